# Optimizing an MI355X kernel written in HIP

```python
import jax, jax.numpy as jnp
from jax import lax
import numpy as np

D_MODEL = 2048
BATCH = 2
SEQ = 8192
DEPTH = 2

CHUNK = 64
N_MIXERS = 2
D_FF = 4 * D_MODEL
NORM_EPS = 1e-6

HGRN_EXPAND = 128
HGRN_HEADS = D_MODEL // HGRN_EXPAND
HGRN_DF = HGRN_HEADS * HGRN_EXPAND
HGRN_DV = D_MODEL // HGRN_HEADS

GLA_HEADS = 4
GLA_KEY_DIM = D_MODEL // 2
GLA_VALUE_DIM = D_MODEL
GLA_DK = GLA_KEY_DIM // GLA_HEADS
GLA_DV = GLA_VALUE_DIM // GLA_HEADS
GLA_GATE_RANK = 16
GLA_GATE_NORMALIZER = 16.0

N_HGRN_LAYERS = (DEPTH + 1) // 2
N_GLA_LAYERS = DEPTH // 2

kernel_name = "hybrid_hgrn2_gla_sqrelu_sandwich"


def rmsnorm(x, w):
    xf = x.astype(jnp.float32)
    y = xf * lax.rsqrt(jnp.mean(xf * xf, axis=-1, keepdims=True) + NORM_EPS)
    return (y * w.astype(jnp.float32)).astype(x.dtype)


def gated_head_norm(o, gain, gate):
    o = o * lax.rsqrt(jnp.mean(o * o, axis=-1, keepdims=True) + NORM_EPS)
    o = o * gain.astype(jnp.float32) * jax.nn.silu(gate.astype(jnp.float32))
    B, T, H, dv = o.shape
    return o.reshape(B, T, H * dv)


def chunk_gated_linear_attention(q, k, v, log_decay):
    B, T, H, dk = q.shape
    dv = v.shape[-1]
    n_chunks = T // CHUNK

    def to_chunks(a):
        a = a.astype(jnp.float32).reshape(B, n_chunks, CHUNK, H, a.shape[-1])
        return a.transpose(1, 0, 3, 2, 4)

    causal = jnp.tril(jnp.ones((CHUNK, CHUNK), dtype=bool))[:, :, None]

    def step(S, inp):
        qi, ki, vi, gi = inp
        b = jnp.cumsum(gi, axis=2)
        o_inter = jnp.einsum('bhid,bhde->bhie', qi * jnp.exp(b), S)
        diff = b[:, :, :, None, :] - b[:, :, None, :, :]
        decay = jnp.exp(jnp.where(causal, diff, -jnp.inf))
        scores = jnp.einsum('bhid,bhjd,bhijd->bhij', qi, ki, decay)
        o = o_inter + jnp.einsum('bhij,bhje->bhie', scores, vi)
        b_last = b[:, :, -1:, :]
        S = jnp.exp(b_last[:, :, 0, :])[..., None] * S + jnp.einsum(
            'bhjd,bhje->bhde', ki * jnp.exp(b_last - b), vi)
        return S, o

    S0 = jnp.zeros((B, H, dk, dv), jnp.float32)
    _, o = lax.scan(step, S0, (to_chunks(q), to_chunks(k), to_chunks(v), to_chunks(log_decay)))
    return o.transpose(1, 0, 3, 2, 4).reshape(B, T, H, dv)


def hgrn2_mixer(h, w_in, lower_bound, norm_w, w_out):
    B, T, _ = h.shape
    proj = h @ w_in
    q, f, i, g = jnp.split(proj, [HGRN_DF, 2 * HGRN_DF, 2 * HGRN_DF + D_MODEL], axis=-1)
    q = jax.nn.silu(q.astype(jnp.float32))
    lb = lower_bound.astype(jnp.float32)
    forget = lb + (1.0 - lb) * jax.nn.sigmoid(f.astype(jnp.float32))
    k = 1.0 - forget
    log_f = jnp.log(forget)
    hd = lambda a, d: a.reshape(B, T, HGRN_HEADS, d)
    o = chunk_gated_linear_attention(hd(q, HGRN_EXPAND), hd(k, HGRN_EXPAND),
                                     hd(i, HGRN_DV), hd(log_f, HGRN_EXPAND))
    o = gated_head_norm(o, norm_w, hd(g, HGRN_DV)).astype(h.dtype)
    return o @ w_out


def gla_mixer(h, w_in, w_gk, b_gk, norm_w, w_out):
    B, T, _ = h.shape
    proj = h @ w_in
    q, k, v, g, r = jnp.split(proj, [GLA_KEY_DIM, 2 * GLA_KEY_DIM, 2 * GLA_KEY_DIM + GLA_VALUE_DIM,
                                     2 * GLA_KEY_DIM + 2 * GLA_VALUE_DIM], axis=-1)
    gk = jax.nn.log_sigmoid((r @ w_gk + b_gk).astype(jnp.float32)) / GLA_GATE_NORMALIZER
    q = q.astype(jnp.float32) * (GLA_DK ** -0.5)
    hd = lambda a, d: a.reshape(B, T, GLA_HEADS, d)
    o = chunk_gated_linear_attention(hd(q, GLA_DK), hd(k, GLA_DK), hd(v, GLA_DV), hd(gk, GLA_DK))
    o = gated_head_norm(o, norm_w, hd(g, GLA_DV)).astype(h.dtype)
    return o @ w_out


def sqrelu_mlp(h, w_up, w_down):
    u = jax.nn.relu(h @ w_up)
    return (u * u) @ w_down


def setup_inputs(seed: int = 0) -> dict:
    key = jax.random.key(seed)
    ks = jax.random.split(key, 20)
    nrm = lambda k, shape, s: jax.random.normal(k, shape, jnp.float32) * s
    gain = lambda k, shape: 1.0 + 0.02 * jax.random.normal(k, shape, jnp.float32)
    hgrn_in = 3 * HGRN_DF + D_MODEL
    gla_in = 2 * GLA_KEY_DIM + 2 * GLA_VALUE_DIM + GLA_GATE_RANK
    return {
        "x": jax.random.normal(ks[0], (BATCH, SEQ, D_MODEL), jnp.float32),
        "norm_mix_pre": gain(ks[1], (DEPTH, D_MODEL)),
        "norm_mix_post": gain(ks[2], (DEPTH, D_MODEL)),
        "norm_mlp_pre": gain(ks[3], (DEPTH, D_MODEL)),
        "norm_mlp_post": gain(ks[4], (DEPTH, D_MODEL)),
        "hgrn_w_in": nrm(ks[5], (N_HGRN_LAYERS, D_MODEL, hgrn_in), D_MODEL ** -0.5),
        "hgrn_lb_logits": nrm(ks[6], (DEPTH + 1, HGRN_DF), 0.1),
        "hgrn_norm": gain(ks[7], (N_HGRN_LAYERS, HGRN_DV)),
        "hgrn_w_out": nrm(ks[8], (N_HGRN_LAYERS, D_MODEL, D_MODEL), D_MODEL ** -0.5),
        "gla_w_in": nrm(ks[9], (N_GLA_LAYERS, D_MODEL, gla_in), D_MODEL ** -0.5),
        "gla_w_gk": nrm(ks[10], (N_GLA_LAYERS, GLA_GATE_RANK, GLA_KEY_DIM), GLA_GATE_RANK ** -0.5),
        "gla_b_gk": nrm(ks[11], (N_GLA_LAYERS, GLA_KEY_DIM), 0.1),
        "gla_norm": gain(ks[12], (N_GLA_LAYERS, GLA_DV)),
        "gla_w_out": nrm(ks[13], (N_GLA_LAYERS, D_MODEL, D_MODEL), D_MODEL ** -0.5),
        "mlp_w_up": nrm(ks[14], (DEPTH, D_MODEL, D_FF), D_MODEL ** -0.5),
        "mlp_w_down": nrm(ks[15], (DEPTH, D_FF, D_MODEL), D_FF ** -0.5),
    }


def reference(x, norm_mix_pre, norm_mix_post, norm_mlp_pre, norm_mlp_post,
              hgrn_w_in, hgrn_lb_logits, hgrn_norm, hgrn_w_out,
              gla_w_in, gla_w_gk, gla_b_gk, gla_norm, gla_w_out,
              mlp_w_up, mlp_w_down):
    lower_bounds = jnp.cumsum(jax.nn.softmax(hgrn_lb_logits.astype(jnp.float32), axis=0), axis=0)
    h = x
    for i in range(DEPTH):
        hn = rmsnorm(h, norm_mix_pre[i])
        j = i // N_MIXERS
        if i % N_MIXERS == 0:
            m = hgrn2_mixer(hn, hgrn_w_in[j], lower_bounds[i], hgrn_norm[j], hgrn_w_out[j])
        else:
            m = gla_mixer(hn, gla_w_in[j], gla_w_gk[j], gla_b_gk[j], gla_norm[j], gla_w_out[j])
        h = h + rmsnorm(m, norm_mix_post[i])
        f = sqrelu_mlp(rmsnorm(h, norm_mlp_pre[i]), mlp_w_up[i], mlp_w_down[i])
        h = h + rmsnorm(f, norm_mlp_post[i])
    return h
```

```cpp
#include <hip/hip_runtime.h>
#include <hip/hip_cooperative_groups.h>
#include <cstdio>
#include <cstdint>
namespace cg = cooperative_groups;
namespace pg8 {
#define PG8_LAS __attribute__((address_space(3)))
typedef unsigned short bf16_t;
typedef short bf16x8 __attribute__((ext_vector_type(8)));
typedef float f32x4 __attribute__((ext_vector_type(4)));
typedef unsigned u32x4 __attribute__((ext_vector_type(4)));
constexpr int BM = 256, BK = 64, HALF = 128, HTB = HALF * BK * 2  , STAGE_BYTES = 8 * HTB, NXCD = 8, WGM = 8;

__host__ __device__ __forceinline__ int lds_byte(int r, int c) { const int st = (r >> 4) * 2 + (c >> 5), rr = r & 15, cc = c & 31, ob = rr * 64 + cc * 2; return st * 1024 + (ob ^ (((ob >> 9) & 1) << 5)); }
__host__ __device__ __forceinline__ void stage_rc(int b, int& R, int& C) { const int st = b / 1024, sb = b % 1024, swz = sb ^ (((sb >> 9) & 1) << 5); R = (st >> 1) * 16 + swz / 64; C = (st & 1) * 32 + (swz % 64) / 2; }
__host__ __device__ __forceinline__ int perm32(int rho) { const int n = rho >> 4, i = rho & 15; return 8 * (i >> 2) + 4 * n + (i & 3); }

struct Unit { int pm, pn; };
struct Gemm { const bf16_t* A; const bf16_t* Bt; int M, N, K; };

struct StaticOrder {
    int nM, nN, nwg, G, c;
    __host__ __device__ void init(int M, int N, int G_, int c_) { nM = M / BM; nN = N / BM; nwg = nM * nN; G = G_; c = c_; }
    __host__ __device__ bool next(int i, Unit& u) const {
        const long L = (long)i * G + c; if (L >= nwg) return false;
        int wgid = (int)L; { const int q = nwg / NXCD, r = nwg % NXCD, xcd = wgid % NXCD, off = wgid / NXCD; wgid = (xcd < r ? xcd * (q + 1) : r * (q + 1) + (xcd - r) * q) + off; }
        const int nig = WGM * nN, gid = wgid / nig, fm = gid * WGM, gsz = (nM - fm) < WGM ? (nM - fm) : WGM;
        u.pm = fm + ((wgid % nig) % gsz); u.pn = (wgid % nig) / gsz; return true;
    }
    __device__ __forceinline__ void a_ready(const Unit&) const {}
    __device__ __forceinline__ void done(const Unit&) const {}
};

typedef float f32x2_t __attribute__((ext_vector_type(2)));
typedef __bf16 bf16x2_t __attribute__((ext_vector_type(2)));
__device__ __forceinline__ unsigned cvt_pk_bf16(float lo, float hi) { f32x2_t v = {lo, hi}; bf16x2_t b = __builtin_convertvector(v, bf16x2_t); return __builtin_bit_cast(unsigned, b); }
template <class Epi, class Sched, bool ALIGN_EPI = false, bool SP2 = false>
__device__ __forceinline__ void gemm_phase(PG8_LAS unsigned char* lds, const Gemm g, const Sched& S, const Epi& E) {
    const int tid = threadIdx.x, wid = __builtin_amdgcn_readfirstlane(tid >> 6), lane = tid & 63, wr = wid >> 2, wc = wid & 3, fr = lane & 15, fq = lane >> 4;
    const int K = g.K, nt = K / BK;
    unsigned voffA[2], voffB[2];
#pragma unroll
    for (int i = 0; i < 2; ++i) { int R, C; stage_rc(tid * 16 + i * 8192, R, C); const int Rb = Epi::PERM ? ((R & ~31) + perm32(R & 31)) : R;
        voffA[i] = (unsigned)(R * K + C) * 2u; voffB[i] = (unsigned)(Rb * K + C) * 2u; }
    const size_t kstep = (size_t)(BK * 2);
    const size_t hstep = (size_t)HALF * K * 2;
    const size_t tstep = 2 * hstep;
    const unsigned ldsw = (unsigned)wid * 1024u;
    const int aoff = lds_byte(wr * 64 + fr, fq * 8), boff = lds_byte(wc * 32 + fr, fq * 8);
#define PG8_SA(b, h) (((b) * 2 + (h)) * HTB)
#define PG8_SB(b, h) ((4 + (b) * 2 + (h)) * HTB)
#define PG8_STAGE(bufoff, gbase, voff) do { _Pragma("unroll") for (int _i = 0; _i < 2; ++_i) \
        __builtin_amdgcn_global_load_lds((const unsigned*)((const char*)(gbase) + (voff)[_i]), (PG8_LAS unsigned*)(lds + (bufoff) + ldsw + _i * 8192), 16, 0, 0); } while (0)
#define PG8_LDA(dst, b, h) do { _Pragma("unroll") for (int m = 0; m < 4; ++m) _Pragma("unroll") for (int k = 0; k < 2; ++k) dst[m][k] = *(const PG8_LAS bf16x8*)(lds + PG8_SA(b, h) + aoff + m * 2048 + k * 1024); } while (0)
#define PG8_LDB(dst, b, h) do { _Pragma("unroll") for (int n = 0; n < 2; ++n) _Pragma("unroll") for (int k = 0; k < 2; ++k) dst[n][k] = *(const PG8_LAS bf16x8*)(lds + PG8_SB(b, h) + boff + n * 2048 + k * 1024); } while (0)
#define PG8_MMA(ai, bj, At, Bt) do { __builtin_amdgcn_s_setprio(1); _Pragma("unroll") for (int m = 0; m < 4; ++m) _Pragma("unroll") for (int n = 0; n < 2; ++n) _Pragma("unroll") for (int k = 0; k < 2; ++k) \
        acc[ai][bj][m][n] = __builtin_amdgcn_mfma_f32_16x16x32_bf16(Bt[n][k], At[m][k], acc[ai][bj][m][n], 0, 0, 0); __builtin_amdgcn_s_setprio(0); } while (0)
#define PG8_WAIT_V(n) asm volatile("s_waitcnt vmcnt(" #n ")" ::: "memory")
#define PG8_WAIT_L(n) asm volatile("s_waitcnt lgkmcnt(" #n ")" ::: "memory")
#define PG8_BAR __builtin_amdgcn_s_barrier()
#define PG8_SCHED __builtin_amdgcn_sched_barrier(0)
    Unit cur, nxt; int ui = 0;
    if (!S.next(0, cur)) return;
    f32x4 acc[2][2][4][2];
#pragma unroll
    for (int a = 0; a < 2; ++a)
#pragma unroll
        for (int b = 0; b < 2; ++b)
#pragma unroll
            for (int m = 0; m < 4; ++m)
#pragma unroll
                for (int n = 0; n < 2; ++n) acc[a][b][m][n] = (f32x4){0.f, 0.f, 0.f, 0.f};
    bf16x8 At[4][2], B0[2][2], B1[2][2];
    const char* cA = (const char*)g.A + (size_t)cur.pm * tstep; const char* cB = (const char*)g.Bt + (size_t)cur.pn * tstep;
    S.a_ready(cur);
    if constexpr (SP2) {
        PG8_STAGE(PG8_SB(0, 0), cB, voffB); PG8_STAGE(PG8_SB(0, 1), cB + hstep, voffB); PG8_STAGE(PG8_SA(0, 0), cA, voffA); PG8_STAGE(PG8_SA(0, 1), cA + hstep, voffA);
        if (wr == 1) PG8_BAR;
        PG8_WAIT_V(2); PG8_BAR;
        PG8_STAGE(PG8_SB(1, 0), cB + kstep, voffB); PG8_STAGE(PG8_SA(1, 0), cA + kstep, voffA); PG8_STAGE(PG8_SB(1, 1), cB + hstep + kstep, voffB);
        PG8_WAIT_V(6); PG8_BAR;
    } else {
        PG8_STAGE(PG8_SB(0, 0), cB, voffB); PG8_STAGE(PG8_SA(0, 0), cA, voffA); PG8_STAGE(PG8_SB(0, 1), cB + hstep, voffB); PG8_STAGE(PG8_SA(0, 1), cA + hstep, voffA);
        if (wr == 1) PG8_BAR;
        PG8_WAIT_V(4); PG8_BAR;
        PG8_STAGE(PG8_SB(1, 0), cB + kstep, voffB); PG8_STAGE(PG8_SA(1, 0), cA + kstep, voffA); PG8_STAGE(PG8_SB(1, 1), cB + hstep + kstep, voffB);
        PG8_WAIT_V(6); PG8_BAR;
    }
    for (;;) {
        const bool has_next = S.next(ui + 1, nxt);
        const char* nA = has_next ? (const char*)g.A + (size_t)nxt.pm * tstep : cA; const char* nB = has_next ? (const char*)g.Bt + (size_t)nxt.pn * tstep : cB;
        for (int t = 0; t < nt; t += 2) {
            const bool last = (t == nt - 2);
            const char* a1 = cA + (size_t)(t + 1) * kstep;
            const char* a2 = last ? nA : cA + (size_t)(t + 2) * kstep; const char* b2 = last ? nB : cB + (size_t)(t + 2) * kstep;
            const char* a3 = a2 + kstep; const char* b3 = b2 + kstep;
            if (last && has_next) S.a_ready(nxt);
            if constexpr (SP2) {
            PG8_LDB(B0, 0, 0); PG8_LDB(B1, 0, 1); PG8_SCHED; PG8_LDA(At, 0, 0); PG8_STAGE(PG8_SA(1, 1), a1 + hstep, voffA);
            PG8_WAIT_V(8); PG8_WAIT_L(0); PG8_BAR; PG8_MMA(0, 0, At, B0); PG8_MMA(0, 1, At, B1); PG8_BAR; PG8_SCHED;
            PG8_LDA(At, 0, 1); PG8_STAGE(PG8_SB(0, 0), b2, voffB); PG8_STAGE(PG8_SB(0, 1), b2 + hstep, voffB); PG8_STAGE(PG8_SA(0, 0), a2, voffA);
            PG8_WAIT_V(8); PG8_WAIT_L(0); PG8_BAR; PG8_MMA(1, 0, At, B0); PG8_MMA(1, 1, At, B1); PG8_BAR; PG8_SCHED;
            PG8_LDB(B0, 1, 0); PG8_LDB(B1, 1, 1); PG8_SCHED; PG8_LDA(At, 1, 0); PG8_STAGE(PG8_SA(0, 1), a2 + hstep, voffA);
            PG8_WAIT_V(8); PG8_WAIT_L(0); PG8_BAR; PG8_MMA(0, 0, At, B0); PG8_MMA(0, 1, At, B1); PG8_BAR; PG8_SCHED;
            PG8_LDA(At, 1, 1); PG8_STAGE(PG8_SB(1, 0), b3, voffB); PG8_STAGE(PG8_SB(1, 1), b3 + hstep, voffB); PG8_STAGE(PG8_SA(1, 0), a3, voffA);
            PG8_WAIT_V(8); PG8_WAIT_L(0); PG8_BAR; PG8_MMA(1, 0, At, B0); PG8_MMA(1, 1, At, B1); PG8_BAR; PG8_SCHED;
            } else {
            PG8_LDB(B0, 0, 0); PG8_SCHED; PG8_LDA(At, 0, 0); PG8_STAGE(PG8_SA(1, 1), a1 + hstep, voffA);
            PG8_WAIT_L(8); PG8_BAR; PG8_WAIT_L(0); PG8_MMA(0, 0, At, B0); PG8_BAR; PG8_SCHED;
            PG8_LDB(B1, 0, 1); PG8_STAGE(PG8_SB(0, 0), b2, voffB);
            PG8_BAR; PG8_WAIT_L(0); PG8_MMA(0, 1, At, B1); PG8_BAR;
            PG8_LDA(At, 0, 1); PG8_STAGE(PG8_SA(0, 0), a2, voffA);
            PG8_BAR; PG8_WAIT_L(0); PG8_MMA(1, 0, At, B0); PG8_BAR; PG8_SCHED;
            PG8_STAGE(PG8_SB(0, 1), b2 + hstep, voffB);
            PG8_WAIT_V(6); PG8_BAR; PG8_MMA(1, 1, At, B1); PG8_BAR;
            PG8_LDB(B0, 1, 0); PG8_SCHED; PG8_LDA(At, 1, 0); PG8_STAGE(PG8_SA(0, 1), a2 + hstep, voffA);
            PG8_WAIT_L(8); PG8_BAR; PG8_WAIT_L(0); PG8_MMA(0, 0, At, B0); PG8_BAR; PG8_SCHED;
            PG8_LDB(B1, 1, 1); PG8_STAGE(PG8_SB(1, 0), b3, voffB);
            PG8_BAR; PG8_WAIT_L(0); PG8_MMA(0, 1, At, B1); PG8_BAR;
            PG8_LDA(At, 1, 1); PG8_STAGE(PG8_SA(1, 0), a3, voffA);
            PG8_BAR; PG8_WAIT_L(0); PG8_MMA(1, 0, At, B0); PG8_BAR; PG8_SCHED;
            PG8_STAGE(PG8_SB(1, 1), b3 + hstep, voffB);
            PG8_WAIT_V(6); PG8_BAR; PG8_MMA(1, 1, At, B1); PG8_BAR;
            }
        }
        if constexpr (ALIGN_EPI) { if (wr == 0) PG8_BAR; }
        if constexpr (!Epi::AFTER_DRAIN) { E(acc, cur, wr, wc, fr, fq); S.done(cur); }
        if (!has_next) break;
#pragma unroll
        for (int a = 0; a < 2; ++a)
#pragma unroll
            for (int b = 0; b < 2; ++b)
#pragma unroll
                for (int m = 0; m < 4; ++m)
#pragma unroll
                    for (int n = 0; n < 2; ++n) acc[a][b][m][n] = (f32x4){0.f, 0.f, 0.f, 0.f};
        cur = nxt; cA = nA; cB = nB; ++ui;
        if constexpr (ALIGN_EPI) { if (wr == 1) PG8_BAR; }
    }
    PG8_WAIT_V(0);
    if constexpr (!ALIGN_EPI) { if (wr == 0) PG8_BAR; }
    PG8_BAR;
    if constexpr (Epi::AFTER_DRAIN) { E.fused(acc, cur, wr, wc, fr, fq, lds, wid, lane); S.done(cur); }
#undef PG8_SA
#undef PG8_SB
#undef PG8_STAGE
#undef PG8_LDA
#undef PG8_LDB
#undef PG8_MMA
#undef PG8_WAIT_V
#undef PG8_WAIT_L
#undef PG8_BAR
#undef PG8_SCHED
}
}

#ifndef MK_N_LAUNCHES
#define MK_N_LAUNCHES 1
#endif
#define LAS __attribute__((address_space(3)))
typedef unsigned short bf16_t;
typedef short bf16x8 __attribute__((ext_vector_type(8)));
typedef float f32x4 __attribute__((ext_vector_type(4)));
typedef unsigned u32x4 __attribute__((ext_vector_type(4)));
typedef unsigned u32x2 __attribute__((ext_vector_type(2)));
using pg8::cvt_pk_bf16;

constexpr int MTOK = 16384, DM = 2048, DFF = 8192, SEQ = 8192, NBATCH = 2, CHUNK = 64, NCHUNK = MTOK / CHUNK, CPB = SEQ / CHUNK;
constexpr float NEPS = 1e-6f;
constexpr int GLA_IN = 6160, GLA_NPAD = 6400;
constexpr size_t MiB = 1u << 20;
constexpr size_t WS_W = 0;
constexpr size_t W0IN = 0, W0OUT = 32 * MiB, W0UP = 40 * MiB, W0DN = 72 * MiB;
constexpr size_t W1IN = 0, W1OUT = 25 * MiB, W1UP = 33 * MiB, W1DN = 65 * MiB;
constexpr size_t WS_Q = 104 * MiB, WS_K0 = 168 * MiB, WS_K1 = 136 * MiB, WS_V = 232 * MiB, WS_G = 296 * MiB, WS_U = 104 * MiB;
constexpr size_t WS_A = 360 * MiB;
constexpr size_t WS_F = 424 * MiB;
constexpr size_t WS_AL = 488 * MiB, WS_BE = 490 * MiB, WS_GA = 492 * MiB;
constexpr size_t WS_SS = 494 * MiB;
constexpr size_t WS_R16 = 502 * MiB;
constexpr size_t WS_LB = 503 * MiB;
constexpr size_t WS_END = 504 * MiB;
constexpr int LDS_BYTES = 147456;
constexpr int NTHREADS = 512;

enum { PH_PRO = 0, PH_G1, PH_PREP0, PH_SCAN0, PH_HN0, PH_G2, PH_ROW0A, PH_G3, PH_G4, PH_ROW0B, PH_G5, PH_PREP1, PH_SCAN1, PH_HN1, PH_G6, PH_ROW1A, PH_G7, PH_G8, PH_ROW1B, NPH };
enum { E_PLAIN = 0, E_RELU2, E_HGRN_IN, E_GLA_IN };
enum { M_NONE = 0, M_SILU, M_RELU2, M_FGATE, M_R16 };

#define LDS_WAIT() asm volatile("s_waitcnt lgkmcnt(0)" ::: "memory")
#define LDS_BAR() do { asm volatile("s_waitcnt lgkmcnt(0)" ::: "memory"); __builtin_amdgcn_s_barrier(); asm volatile("" ::: "memory"); } while (0)

__device__ __forceinline__ float bf2f(unsigned short b) { return __uint_as_float(((unsigned)b) << 16); }
__device__ __forceinline__ float bflo(unsigned w) { return __uint_as_float(w << 16); }
__device__ __forceinline__ float bfhi(unsigned w) { return __uint_as_float(w & 0xffff0000u); }
__device__ __forceinline__ float wave_sum(float v) {
#pragma unroll
    for (int o = 1; o < 64; o <<= 1) v += __shfl_xor(v, o);
    return v;
}

template <int cfg> struct Epi {
    static constexpr bool PERM = true, AFTER_DRAIN = false;
    unsigned char* ws; float* dout;
    __device__ __forceinline__ void operator()(const f32x4 (&acc)[2][2][4][2], const pg8::Unit& u, int wr, int wc, int fr, int fq) const {
        const int row0 = u.pm * 256 + wr * 64 + fr;
        const int cin = wc * 32 + 8 * fq;
        int mode = M_NONE, ldo = DM, colt = u.pn * 256; float sc = 1.f; bf16_t* O = (bf16_t*)(ws + WS_F);
        if (cfg == E_RELU2) { mode = M_RELU2; O = (bf16_t*)(ws + WS_U); ldo = DFF; }
        else if (cfg == E_HGRN_IN) {
            const int seg = u.pn >> 3; colt = (u.pn & 7) * 256;
            if (seg == 0) { mode = M_SILU; O = (bf16_t*)(ws + WS_Q); }
            else if (seg == 1) { mode = M_FGATE; O = (bf16_t*)(ws + WS_K0); }
            else if (seg == 2) { O = (bf16_t*)(ws + WS_V); }
            else { O = (bf16_t*)(ws + WS_G); }
        } else if (cfg == E_GLA_IN) {
            if (u.pn < 4) { O = (bf16_t*)(ws + WS_Q); ldo = 1024; sc = 0.0625f; }
            else if (u.pn < 8) { O = (bf16_t*)(ws + WS_K1); ldo = 1024; colt = (u.pn - 4) * 256; }
            else if (u.pn < 16) { O = (bf16_t*)(ws + WS_V); colt = (u.pn - 8) * 256; }
            else if (u.pn < 24) { O = (bf16_t*)(ws + WS_G); colt = (u.pn - 16) * 256; }
            else { mode = M_R16; }
        }
        if (mode == M_FGATE) {
            const float* lb = (const float*)(ws + WS_LB);
#pragma unroll
            for (int bj = 0; bj < 2; ++bj) {
                const int col = colt + bj * 128 + cin;
                const f32x4 l0 = *(const f32x4*)(lb + col), l1 = *(const f32x4*)(lb + col + 4);
#pragma unroll
                for (int ai = 0; ai < 2; ++ai)
#pragma unroll
                    for (int m = 0; m < 4; ++m) {
                        const size_t row = (size_t)(row0 + ai * 128 + m * 16);
                        f32x4 k0, k1, f0, f1;
#pragma unroll
                        for (int j = 0; j < 4; ++j) {
                            const float a = acc[ai][bj][m][0][j], b = acc[ai][bj][m][1][j];
                            k0[j] = (1.f - l0[j]) * __builtin_amdgcn_rcpf(1.f + __expf(a)); k1[j] = (1.f - l1[j]) * __builtin_amdgcn_rcpf(1.f + __expf(b));
                            f0[j] = __logf(1.f - k0[j]); f1[j] = __logf(1.f - k1[j]);
                        }
                        u32x4 w; w.x = cvt_pk_bf16(k0[0], k0[1]); w.y = cvt_pk_bf16(k0[2], k0[3]); w.z = cvt_pk_bf16(k1[0], k1[1]); w.w = cvt_pk_bf16(k1[2], k1[3]);
                        *(u32x4*)(O + row * DM + col) = w;
                        *(f32x4*)(dout + row * DM + col) = f0; *(f32x4*)(dout + row * DM + col + 4) = f1;
                    }
            }
        } else if (mode == M_R16) {
            if (wc == 0 && fq < 2) {
                float* R = (float*)(ws + WS_R16);
#pragma unroll
                for (int ai = 0; ai < 2; ++ai)
#pragma unroll
                    for (int m = 0; m < 4; ++m) {
                        const size_t row = (size_t)(row0 + ai * 128 + m * 16);
                        *(f32x4*)(R + row * 16 + 8 * fq) = acc[ai][0][m][0]; *(f32x4*)(R + row * 16 + 8 * fq + 4) = acc[ai][0][m][1];
                    }
            }
        } else {
#pragma unroll
            for (int ai = 0; ai < 2; ++ai)
#pragma unroll
                for (int m = 0; m < 4; ++m) {
                    bf16_t* rowp = O + (size_t)(row0 + ai * 128 + m * 16) * ldo + colt + cin;
#pragma unroll
                    for (int bj = 0; bj < 2; ++bj) {
                        f32x4 v0 = acc[ai][bj][m][0], v1 = acc[ai][bj][m][1];
                        if (mode == M_SILU) {
#pragma unroll
                            for (int j = 0; j < 4; ++j) { v0[j] = v0[j] / (1.f + __expf(-v0[j])); v1[j] = v1[j] / (1.f + __expf(-v1[j])); }
                        } else if (mode == M_RELU2) {
#pragma unroll
                            for (int j = 0; j < 4; ++j) { const float a = fmaxf(v0[j], 0.f), b = fmaxf(v1[j], 0.f); v0[j] = a * a; v1[j] = b * b; }
                        } else { v0 = v0 * sc; v1 = v1 * sc; }
                        u32x4 w; w.x = cvt_pk_bf16(v0[0], v0[1]); w.y = cvt_pk_bf16(v0[2], v0[3]); w.z = cvt_pk_bf16(v1[0], v1[1]); w.w = cvt_pk_bf16(v1[2], v1[3]);
                        *(u32x4*)(rowp + bj * 128) = w;
                    }
                }
        }
    }
};

__device__ __forceinline__ void transpose_item(const float* W, int ldw, int nvalid, bf16_t* WT, int K, LAS float* scr, int kb, int nb, int lane) {
    const int k0 = 64 * kb, n0 = 32 * nb;
    const int n = n0 + (lane & 31);
#pragma unroll 8
    for (int i = 0; i < 32; ++i) { const int kk = 2 * i + (lane >> 5); scr[kk * 33 + (lane & 31)] = (n < nvalid) ? W[(size_t)(k0 + kk) * ldw + n] : 0.f; }
    LDS_WAIT();
    const int c = lane & 7;
#pragma unroll
    for (int j = 0; j < 4; ++j) { const int nn = (lane >> 3) + 8 * j; const LAS float* s = scr + (8 * c) * 33 + nn;
        u32x4 o; o.x = cvt_pk_bf16(s[0 * 33], s[1 * 33]); o.y = cvt_pk_bf16(s[2 * 33], s[3 * 33]); o.z = cvt_pk_bf16(s[4 * 33], s[5 * 33]); o.w = cvt_pk_bf16(s[6 * 33], s[7 * 33]);
        *(u32x4*)(WT + (size_t)(n0 + nn) * K + k0 + 8 * c) = o; }
    LDS_WAIT();
}
__device__ __forceinline__ void convert_layer(LAS unsigned char* L, int gw, int ngw, int wave, int lane, const float* w_in, int ld_in, int nvalid_in, int nrows_in, const float* w_out, const float* w_up, const float* w_dn,
                                              bf16_t* t_in, bf16_t* t_out, bf16_t* t_up, bf16_t* t_dn) {
    LAS float* scr = (LAS float*)(L + wave * 8448);
    const int nb_in = nrows_in / 32;
    const int I_IN = (DM / 64) * nb_in, I_OUT = (DM / 64) * (DM / 32), I_UP = (DM / 64) * (DFF / 32), I_DN = (DFF / 64) * (DM / 32);
    const int NIT = I_IN + I_OUT + I_UP + I_DN;
    for (int it = gw; it < NIT; it += ngw) {
        int r = it;
        if (r < I_IN) { transpose_item(w_in, ld_in, nvalid_in, t_in, DM, scr, r / nb_in, r % nb_in, lane); continue; } r -= I_IN;
        if (r < I_OUT) { transpose_item(w_out, DM, DM, t_out, DM, scr, r / (DM / 32), r % (DM / 32), lane); continue; } r -= I_OUT;
        if (r < I_UP) { transpose_item(w_up, DFF, DFF, t_up, DM, scr, r / (DFF / 32), r % (DFF / 32), lane); continue; } r -= I_UP;
        transpose_item(w_dn, DM, DM, t_dn, DFF, scr, r / (DM / 32), r % (DM / 32), lane);
    }
}

__device__ __forceinline__ void row_pass(int gw, int ngw, int lane, const bf16_t* msrc, const float* hin, const float* wpost, float* hout, const float* wpre, bf16_t* hn) {
    for (int row = gw; row < MTOK; row += ngw) {
        f32x4 h[4][2];
#pragma unroll
        for (int j = 0; j < 4; ++j) { const float* p = hin + (size_t)row * DM + j * 512 + lane * 8; h[j][0] = *(const f32x4*)p; h[j][1] = *(const f32x4*)(p + 4); }
        if (msrc) {
            f32x4 mv[4][2]; float ss = 0.f;
#pragma unroll
            for (int j = 0; j < 4; ++j) { const u32x4 w = *(const u32x4*)(msrc + (size_t)row * DM + j * 512 + lane * 8);
                mv[j][0] = (f32x4){bflo(w.x), bfhi(w.x), bflo(w.y), bfhi(w.y)}; mv[j][1] = (f32x4){bflo(w.z), bfhi(w.z), bflo(w.w), bfhi(w.w)};
#pragma unroll
                for (int q = 0; q < 4; ++q) ss += mv[j][0][q] * mv[j][0][q] + mv[j][1][q] * mv[j][1][q]; }
            const float rstd = rsqrtf(wave_sum(ss) * (1.f / DM) + NEPS);
#pragma unroll
            for (int j = 0; j < 4; ++j) { const float* wp = wpost + j * 512 + lane * 8; const f32x4 w0 = *(const f32x4*)wp, w1 = *(const f32x4*)(wp + 4);
                h[j][0] = h[j][0] + mv[j][0] * rstd * w0; h[j][1] = h[j][1] + mv[j][1] * rstd * w1;
                float* op = hout + (size_t)row * DM + j * 512 + lane * 8; *(f32x4*)op = h[j][0]; *(f32x4*)(op + 4) = h[j][1]; }
        }
        if (wpre) {
            float ss = 0.f;
#pragma unroll
            for (int j = 0; j < 4; ++j)
#pragma unroll
                for (int q = 0; q < 4; ++q) ss += h[j][0][q] * h[j][0][q] + h[j][1][q] * h[j][1][q];
            const float rstd = rsqrtf(wave_sum(ss) * (1.f / DM) + NEPS);
#pragma unroll
            for (int j = 0; j < 4; ++j) { const float* wp = wpre + j * 512 + lane * 8; const f32x4 w0 = *(const f32x4*)wp, w1 = *(const f32x4*)(wp + 4);
                const f32x4 a = h[j][0] * rstd * w0, b = h[j][1] * rstd * w1;
                u32x4 o; o.x = cvt_pk_bf16(a[0], a[1]); o.y = cvt_pk_bf16(a[2], a[3]); o.z = cvt_pk_bf16(b[0], b[1]); o.w = cvt_pk_bf16(b[2], b[3]);
                *(u32x4*)(hn + (size_t)row * DM + j * 512 + lane * 8) = o; }
        }
    }
}

template <int DK, int DV, int H, bool GLA>
__device__ __forceinline__ void prep_phase(LAS unsigned char* L, int tid, bf16_t* Q, const bf16_t* Kin, const float* LF, const float* R16, const float* wgk, const float* bgk,
                                           const bf16_t* V, bf16_t* Ktt, float* AL, float* BE, float* GA, bf16_t* OI) {
    constexpr int DKT = DK * H, DVT = DV * H, NSEG = NTHREADS / DK, SEGL = 64 / NSEG, QSTR = DK + 8, PSTR = 72, DVC = (DV > 256) ? 256 : DV;
    constexpr int OFF_QS = 0, OFF_KS = 64 * QSTR * 2, OFF_P = 2 * 64 * QSTR * 2, OFF_VT = OFF_P + 64 * PSTR * 2, OFF_SEG = OFF_VT + DVC * PSTR * 2;
    static_assert(OFF_SEG + NSEG * DK * 4 <= 131072, "prep LDS");
    LAS bf16_t* Qs = (LAS bf16_t*)(L + OFF_QS); LAS bf16_t* Ks = (LAS bf16_t*)(L + OFF_KS); LAS bf16_t* Ps = (LAS bf16_t*)(L + OFF_P); LAS bf16_t* Vt = (LAS bf16_t*)(L + OFF_VT);
    LAS float* segsum = (LAS float*)(L + OFF_SEG);
    const int lane = tid & 63, wid = __builtin_amdgcn_readfirstlane(tid >> 6), fr = lane & 15, fg = lane >> 4;
    const int col = tid % DK, seg = __builtin_amdgcn_readfirstlane(tid / DK);
    for (int tile = blockIdx.x; tile < NCHUNK * H; tile += gridDim.x) {
        const int h = tile % H, cgi = tile / H, token0 = cgi * CHUNK, gcol = h * DK + col;
        float g[SEGL];
        if (GLA) {
            float wk[16];
#pragma unroll
            for (int r = 0; r < 16; ++r) wk[r] = wgk[r * DKT + gcol];
            const float bk = bgk[gcol];
#pragma unroll
            for (int i = 0; i < SEGL; ++i) {
                const float* rp = R16 + (size_t)(token0 + seg * SEGL + i) * 16;
                float z = bk;
#pragma unroll
                for (int r = 0; r < 16; ++r) z += rp[r] * wk[r];
                g[i] = (fminf(z, 0.f) - log1pf(expf(-fabsf(z)))) * 0.0625f;
            }
        } else {
#pragma unroll
            for (int i = 0; i < SEGL; ++i) g[i] = LF[(size_t)(token0 + seg * SEGL + i) * DKT + gcol];
        }
#pragma unroll
        for (int i = 1; i < SEGL; ++i) g[i] += g[i - 1];
        segsum[seg * DK + col] = g[SEGL - 1];
        LDS_BAR();
        float pre = 0.f, bref = 0.f, blast = 0.f;
#pragma unroll
        for (int s = 0; s < NSEG; ++s) { const float v = segsum[s * DK + col]; if (s < seg) pre += v; if (s < NSEG / 2) bref += v; blast += v; }
        if (seg == 0) { const size_t vi = (size_t)cgi * DKT + gcol; AL[vi] = expf(bref); BE[vi] = expf(blast - bref); GA[vi] = expf(blast); }
        float kt[SEGL];
#pragma unroll
        for (int i = 0; i < SEGL; ++i) {
            const int tok = seg * SEGL + i; const size_t gi = (size_t)(token0 + tok) * DKT + gcol;
            const float bb = g[i] + pre - bref;
            const float qv = bf2f(Q[gi]) * expf(bb), kv = bf2f(Kin[gi]) * expf(-bb);
            const unsigned short qb = (unsigned short)(cvt_pk_bf16(qv, qv) & 0xffffu);
            Q[gi] = qb; Qs[tok * QSTR + col] = qb; kt[i] = kv;
        }
#pragma unroll
        for (int i = 0; i < SEGL; i += 8) {
            u32x4 w; w.x = cvt_pk_bf16(kt[i], kt[i + 1]); w.y = cvt_pk_bf16(kt[i + 2], kt[i + 3]); w.z = cvt_pk_bf16(kt[i + 4], kt[i + 5]); w.w = cvt_pk_bf16(kt[i + 6], kt[i + 7]);
            *(u32x4*)(Ktt + ((size_t)cgi * DKT + gcol) * 64 + seg * SEGL + i) = w;
#pragma unroll
            for (int q = 0; q < 4; ++q) { Ks[(seg * SEGL + i + 2 * q) * QSTR + col] = (unsigned short)(w[q] & 0xffffu); Ks[(seg * SEGL + i + 2 * q + 1) * QSTR + col] = (unsigned short)(w[q] >> 16); }
        }
        LDS_BAR();
        {
            const int it = wid >> 1;
#pragma unroll
            for (int jj = 0; jj < 2; ++jj) {
                const int jt = 2 * (wid & 1) + jj;
                f32x4 acc = {0.f, 0.f, 0.f, 0.f};
                if (jt <= it) {
#pragma unroll
                    for (int ks = 0; ks < DK / 32; ++ks) {
                        const bf16x8 a = *(const LAS bf16x8*)(Ks + (jt * 16 + fr) * QSTR + ks * 32 + fg * 8);
                        const bf16x8 b = *(const LAS bf16x8*)(Qs + (it * 16 + fr) * QSTR + ks * 32 + fg * 8);
                        acc = __builtin_amdgcn_mfma_f32_16x16x32_bf16(a, b, acc, 0, 0, 0);
                    }
                    if (jt == it) {
#pragma unroll
                        for (int r = 0; r < 4; ++r) if (4 * fg + r > fr) acc[r] = 0.f;
                    }
                }
                u32x2 w; w.x = cvt_pk_bf16(acc[0], acc[1]); w.y = cvt_pk_bf16(acc[2], acc[3]);
                *(LAS u32x2*)(Ps + (it * 16 + fr) * PSTR + jt * 16 + 4 * fg) = w;
            }
        }
#pragma unroll 1
        for (int e0 = 0; e0 < DV; e0 += DVC) {
#pragma unroll
            for (int itx = 0; itx < (64 * DVC / 8) / NTHREADS; ++itx) {
                const int item = itx * NTHREADS + tid, tok = item & 63, e8 = item >> 6;
                const u32x4 w = *(const u32x4*)(V + (size_t)(token0 + tok) * DVT + h * DV + e0 + e8 * 8);
#pragma unroll
                for (int q = 0; q < 4; ++q) { Vt[(e8 * 8 + 2 * q) * PSTR + tok] = (unsigned short)(w[q] & 0xffffu); Vt[(e8 * 8 + 2 * q + 1) * PSTR + tok] = (unsigned short)(w[q] >> 16); }
            }
            LDS_BAR();
            const int it = wid & 3;
            const bf16x8 p0 = *(const LAS bf16x8*)(Ps + (it * 16 + fr) * PSTR + fg * 8), p1 = *(const LAS bf16x8*)(Ps + (it * 16 + fr) * PSTR + 32 + fg * 8);
#pragma unroll
            for (int k = 0; k < DVC / 32; ++k) {
                const int et = (wid >> 2) + 2 * k;
                const bf16x8 a0 = *(const LAS bf16x8*)(Vt + (et * 16 + fr) * PSTR + fg * 8), a1 = *(const LAS bf16x8*)(Vt + (et * 16 + fr) * PSTR + 32 + fg * 8);
                f32x4 acc = {0.f, 0.f, 0.f, 0.f};
                acc = __builtin_amdgcn_mfma_f32_16x16x32_bf16(a0, p0, acc, 0, 0, 0);
                acc = __builtin_amdgcn_mfma_f32_16x16x32_bf16(a1, p1, acc, 0, 0, 0);
                u32x2 w; w.x = cvt_pk_bf16(acc[0], acc[1]); w.y = cvt_pk_bf16(acc[2], acc[3]);
                *(u32x2*)(OI + (size_t)(token0 + it * 16 + fr) * DVT + h * DV + e0 + et * 16 + 4 * fg) = w;
            }
            LDS_BAR();
        }
    }
}

template <int DK, int DV, int H>
__device__ __forceinline__ void scan_phase(LAS unsigned char* L, int tid, const bf16_t* Qt, const bf16_t* Ktt, const bf16_t* V, bf16_t* OI, const float* AL, const float* BE, const float* GA, float* SS) {
    constexpr int DKT = DK * H, DVT = DV * H, NSL = DV / 16, TPW = DK / 128, NKS = DK / 32, SSTR = DK + 8, VSTR = 72;
    LAS bf16_t* St = (LAS bf16_t*)L; LAS bf16_t* Vt = (LAS bf16_t*)(L + 16 * SSTR * 2);
    const int lane = tid & 63, wid = __builtin_amdgcn_readfirstlane(tid >> 6), fr = lane & 15, fg = lane >> 4;
    for (int item = blockIdx.x; item < NBATCH * H * NSL; item += gridDim.x) {
        const int b = item / (H * NSL), h = (item / NSL) % H, sl = item % NSL, ecol0 = h * DV + sl * 16;
        f32x4 S[TPW];
#pragma unroll
        for (int t = 0; t < TPW; ++t) S[t] = (f32x4){0.f, 0.f, 0.f, 0.f};
        bf16x8 kf[TPW][2], qf[NKS]; f32x4 al[TPW], be[TPW], ga[TPW]; u32x2 oi; u32x4 vv;
        bf16x8 kfn[TPW][2], qfn[NKS]; f32x4 aln[TPW], ben[TPW], gan[TPW]; u32x2 oin; u32x4 vvn;
#define SCAN_LOAD(c, kf_, qf_, al_, be_, ga_, oi_, vv_) do { const int cgi_ = b * CPB + (c); const int tk0_ = cgi_ * CHUNK; \
        _Pragma("unroll") for (int t = 0; t < TPW; ++t) { const size_t d_ = (size_t)cgi_ * DKT + h * DK + (wid * TPW + t) * 16; \
            kf_[t][0] = *(const bf16x8*)(Ktt + (d_ + fr) * 64 + fg * 8); kf_[t][1] = *(const bf16x8*)(Ktt + (d_ + fr) * 64 + 32 + fg * 8); \
            al_[t] = *(const f32x4*)(AL + d_ + 4 * fg); be_[t] = *(const f32x4*)(BE + d_ + 4 * fg); ga_[t] = *(const f32x4*)(GA + d_ + 4 * fg); } \
        if (wid < 4) { _Pragma("unroll") for (int ks = 0; ks < NKS; ++ks) qf_[ks] = *(const bf16x8*)(Qt + (size_t)(tk0_ + wid * 16 + fr) * DKT + h * DK + ks * 32 + fg * 8); \
            oi_ = *(const u32x2*)(OI + (size_t)(tk0_ + wid * 16 + fr) * DVT + ecol0 + 4 * fg); } \
        if (tid < 128) vv_ = *(const u32x4*)(V + (size_t)(tk0_ + (tid & 63)) * DVT + ecol0 + 8 * (tid >> 6)); } while (0)
        SCAN_LOAD(0, kf, qf, al, be, ga, oi, vv);
#pragma unroll 1
        for (int c = 0; c < CPB; ++c) {
            const int cn = (c + 1 < CPB) ? c + 1 : c;
            SCAN_LOAD(cn, kfn, qfn, aln, ben, gan, oin, vvn);
            const int token0 = (b * CPB + c) * CHUNK;
#pragma unroll
            for (int t = 0; t < TPW; ++t) { const f32x4 sp = S[t] * al[t]; u32x2 w; w.x = cvt_pk_bf16(sp[0], sp[1]); w.y = cvt_pk_bf16(sp[2], sp[3]);
                *(LAS u32x2*)(St + fr * SSTR + (wid * TPW + t) * 16 + 4 * fg) = w; }
            if (tid < 128) { const int tok = tid & 63, hf = tid >> 6;
#pragma unroll
                for (int q = 0; q < 4; ++q) { Vt[(hf * 8 + 2 * q) * VSTR + tok] = (unsigned short)(vv[q] & 0xffffu); Vt[(hf * 8 + 2 * q + 1) * VSTR + tok] = (unsigned short)(vv[q] >> 16); } }
            LDS_BAR();
            if (wid < 4) {
                f32x4 acc = {0.f, 0.f, 0.f, 0.f};
#pragma unroll
                for (int ks = 0; ks < NKS; ++ks) { const bf16x8 a = *(const LAS bf16x8*)(St + fr * SSTR + ks * 32 + fg * 8); acc = __builtin_amdgcn_mfma_f32_16x16x32_bf16(a, qf[ks], acc, 0, 0, 0); }
                acc[0] += bflo(oi.x); acc[1] += bfhi(oi.x); acc[2] += bflo(oi.y); acc[3] += bfhi(oi.y);
                float ss = acc[0] * acc[0] + acc[1] * acc[1] + acc[2] * acc[2] + acc[3] * acc[3];
                ss += __shfl_xor(ss, 16); ss += __shfl_xor(ss, 32);
                const size_t tok = (size_t)(token0 + wid * 16 + fr);
                u32x2 w; w.x = cvt_pk_bf16(acc[0], acc[1]); w.y = cvt_pk_bf16(acc[2], acc[3]);
                *(u32x2*)(OI + tok * DVT + ecol0 + 4 * fg) = w;
                if (fg == 0) SS[(tok * H + h) * NSL + sl] = ss;
            }
            {
                const bf16x8 v0 = *(const LAS bf16x8*)(Vt + fr * VSTR + fg * 8), v1 = *(const LAS bf16x8*)(Vt + fr * VSTR + 32 + fg * 8);
#pragma unroll
                for (int t = 0; t < TPW; ++t) { f32x4 dS = {0.f, 0.f, 0.f, 0.f};
                    dS = __builtin_amdgcn_mfma_f32_16x16x32_bf16(kf[t][0], v0, dS, 0, 0, 0); dS = __builtin_amdgcn_mfma_f32_16x16x32_bf16(kf[t][1], v1, dS, 0, 0, 0);
                    S[t] = ga[t] * S[t] + be[t] * dS; }
            }
            LDS_BAR();
#pragma unroll
            for (int t = 0; t < TPW; ++t) { kf[t][0] = kfn[t][0]; kf[t][1] = kfn[t][1]; al[t] = aln[t]; be[t] = ben[t]; ga[t] = gan[t]; }
#pragma unroll
            for (int ks = 0; ks < NKS; ++ks) qf[ks] = qfn[ks];
            oi = oin; vv = vvn;
        }
#undef SCAN_LOAD
    }
}

template <int DV, int H>
__device__ __forceinline__ void hn_phase(int gtid, int ngt, const bf16_t* OI, const bf16_t* G, const float* SS, const float* gain, bf16_t* A) {
    constexpr int NSL = DV / 16;
    for (int i = gtid; i < MTOK * (DM / 8); i += ngt) {
        const int token = i >> 8, col = (i & 255) * 8, head = col / DV;
        const float* sp = SS + ((size_t)token * H + head) * NSL; float ss = 0.f;
#pragma unroll
        for (int s = 0; s < NSL; s += 4) { const f32x4 v = *(const f32x4*)(sp + s); ss += (v[0] + v[1]) + (v[2] + v[3]); }
        const float rstd = rsqrtf(ss * (1.f / DV) + NEPS);
        const u32x4 ow = *(const u32x4*)(OI + (size_t)token * DM + col), gw = *(const u32x4*)(G + (size_t)token * DM + col);
        const f32x4 g0 = *(const f32x4*)(gain + (col % DV)), g1 = *(const f32x4*)(gain + (col % DV) + 4);
        float o[8] = {bflo(ow.x), bfhi(ow.x), bflo(ow.y), bfhi(ow.y), bflo(ow.z), bfhi(ow.z), bflo(ow.w), bfhi(ow.w)};
        float gt[8] = {bflo(gw.x), bfhi(gw.x), bflo(gw.y), bfhi(gw.y), bflo(gw.z), bfhi(gw.z), bflo(gw.w), bfhi(gw.w)};
        float r[8];
#pragma unroll
        for (int q = 0; q < 8; ++q) { const float gn = (q < 4) ? g0[q & 3] : g1[q & 3]; r[q] = o[q] * rstd * gn * (gt[q] / (1.f + __expf(-gt[q]))); }
        u32x4 w; w.x = cvt_pk_bf16(r[0], r[1]); w.y = cvt_pk_bf16(r[2], r[3]); w.z = cvt_pk_bf16(r[4], r[5]); w.w = cvt_pk_bf16(r[6], r[7]);
        *(u32x4*)(A + (size_t)token * DM + col) = w;
    }
}

struct Args { const float* in[16]; float* out; unsigned char* ws; int ph_lo, ph_hi; };
__global__ void __launch_bounds__(NTHREADS, 2) fwd_kernel(Args args) {
    __shared__ __attribute__((aligned(16))) unsigned char lds_raw[LDS_BYTES];
    LAS unsigned char* L = (LAS unsigned char*)lds_raw;
    const int tid = threadIdx.x, lane = tid & 63, wave = __builtin_amdgcn_readfirstlane(tid >> 6);
    const int G = gridDim.x, gw = blockIdx.x * 8 + wave, ngw = G * 8, gtid = blockIdx.x * NTHREADS + tid, ngt = G * NTHREADS;
    unsigned char* ws = args.ws; float* dout = args.out;
    const float* x = args.in[0]; const float* n_mix_pre = args.in[1]; const float* n_mix_post = args.in[2]; const float* n_mlp_pre = args.in[3]; const float* n_mlp_post = args.in[4];
    bf16_t* A = (bf16_t*)(ws + WS_A); bf16_t* Fb = (bf16_t*)(ws + WS_F);
    cg::grid_group grid = cg::this_grid();
    const int lo = args.ph_lo, hi = args.ph_hi;
#define IN(k) (lo <= (k) && (k) < hi)
#define SEAM(k) do { if (IN(k) && IN((k) + 1)) grid.sync(); } while (0)
#define GEMM_PHASE(CFG, Aptr, Bptr, N_, K_) do { pg8::Gemm g{(const bf16_t*)(Aptr), (const bf16_t*)(Bptr), MTOK, (N_), (K_)}; pg8::StaticOrder S; S.init(MTOK, (N_), G, (int)blockIdx.x); \
        Epi<CFG> E{ws, dout}; pg8::gemm_phase<Epi<CFG>, pg8::StaticOrder, true, true>(L, g, S, E); } while (0)
    float* AL = (float*)(ws + WS_AL); float* BE = (float*)(ws + WS_BE); float* GA = (float*)(ws + WS_GA); float* SSp = (float*)(ws + WS_SS);
    if (IN(PH_PRO)) {
        convert_layer(L, gw, ngw, wave, lane, args.in[5], DFF, DFF, DFF, args.in[8], args.in[14], args.in[15],
                      (bf16_t*)(ws + W0IN), (bf16_t*)(ws + W0OUT), (bf16_t*)(ws + W0UP), (bf16_t*)(ws + W0DN));
        { const float* lg = args.in[6]; float* lb = (float*)(ws + WS_LB);
          for (int i = gtid; i < DM; i += ngt) { const float a = lg[i], b = lg[DM + i], c = lg[2 * DM + i]; const float mx = fmaxf(a, fmaxf(b, c));
              const float ea = expf(a - mx), eb = expf(b - mx), ec = expf(c - mx); lb[i] = ea / (ea + eb + ec); } }
        row_pass(gw, ngw, lane, nullptr, x, nullptr, nullptr, n_mix_pre, A);
    }
    SEAM(PH_PRO);
    if (IN(PH_G1)) GEMM_PHASE(E_HGRN_IN, A, ws + W0IN, DFF, DM);
    SEAM(PH_G1);
    if (IN(PH_PREP0)) prep_phase<128, 128, 16, false>(L, tid, (bf16_t*)(ws + WS_Q), (const bf16_t*)(ws + WS_K0), dout, nullptr, nullptr, nullptr, (const bf16_t*)(ws + WS_V), A, AL, BE, GA, Fb);
    SEAM(PH_PREP0);
    if (IN(PH_SCAN0)) scan_phase<128, 128, 16>(L, tid, (const bf16_t*)(ws + WS_Q), A, (const bf16_t*)(ws + WS_V), Fb, AL, BE, GA, SSp);
    SEAM(PH_SCAN0);
    if (IN(PH_HN0)) hn_phase<128, 16>(gtid, ngt, Fb, (const bf16_t*)(ws + WS_G), SSp, args.in[7], A);
    SEAM(PH_HN0);
    if (IN(PH_G2)) GEMM_PHASE(E_PLAIN, A, ws + W0OUT, DM, DM);
    SEAM(PH_G2);
    if (IN(PH_ROW0A)) row_pass(gw, ngw, lane, Fb, x, n_mix_post, dout, n_mlp_pre, A);
    SEAM(PH_ROW0A);
    if (IN(PH_G3)) GEMM_PHASE(E_RELU2, A, ws + W0UP, DFF, DM);
    SEAM(PH_G3);
    if (IN(PH_G4)) GEMM_PHASE(E_PLAIN, ws + WS_U, ws + W0DN, DM, DFF);
    SEAM(PH_G4);
    if (IN(PH_ROW0B)) {
        row_pass(gw, ngw, lane, Fb, dout, n_mlp_post, dout, n_mix_pre + DM, A);
        convert_layer(L, gw, ngw, wave, lane, args.in[9], GLA_IN, GLA_IN, GLA_NPAD, args.in[13], args.in[14] + (size_t)DM * DFF, args.in[15] + (size_t)DM * DFF,
                      (bf16_t*)(ws + W1IN), (bf16_t*)(ws + W1OUT), (bf16_t*)(ws + W1UP), (bf16_t*)(ws + W1DN));
    }
    SEAM(PH_ROW0B);
    if (IN(PH_G5)) GEMM_PHASE(E_GLA_IN, A, ws + W1IN, GLA_NPAD, DM);
    SEAM(PH_G5);
    if (IN(PH_PREP1)) prep_phase<256, 512, 4, true>(L, tid, (bf16_t*)(ws + WS_Q), (const bf16_t*)(ws + WS_K1), nullptr, (const float*)(ws + WS_R16), args.in[10], args.in[11], (const bf16_t*)(ws + WS_V), A, AL, BE, GA, Fb);
    SEAM(PH_PREP1);
    if (IN(PH_SCAN1)) scan_phase<256, 512, 4>(L, tid, (const bf16_t*)(ws + WS_Q), A, (const bf16_t*)(ws + WS_V), Fb, AL, BE, GA, SSp);
    SEAM(PH_SCAN1);
    if (IN(PH_HN1)) hn_phase<512, 4>(gtid, ngt, Fb, (const bf16_t*)(ws + WS_G), SSp, args.in[12], A);
    SEAM(PH_HN1);
    if (IN(PH_G6)) GEMM_PHASE(E_PLAIN, A, ws + W1OUT, DM, DM);
    SEAM(PH_G6);
    if (IN(PH_ROW1A)) row_pass(gw, ngw, lane, Fb, dout, n_mix_post + DM, dout, n_mlp_pre + DM, A);
    SEAM(PH_ROW1A);
    if (IN(PH_G7)) GEMM_PHASE(E_RELU2, A, ws + W1UP, DFF, DM);
    SEAM(PH_G7);
    if (IN(PH_G8)) GEMM_PHASE(E_PLAIN, ws + WS_U, ws + W1DN, DM, DFF);
    SEAM(PH_G8);
    if (IN(PH_ROW1B)) row_pass(gw, ngw, lane, Fb, dout, n_mlp_post + DM, dout, nullptr, nullptr);
#undef IN
#undef SEAM
#undef GEMM_PHASE
#ifdef DIAG_PREFIX
    grid.sync();
    for (int i = gtid; i < MTOK * DM; i += ngt) {
        unsigned hsh = __float_as_uint(dout[i]); hsh = (hsh >> 16) ^ (hsh & 0xffffu);
        for (int k = 0; k < 8; ++k) { const size_t widx = (size_t)i + (size_t)k * 33554432u; if (widx * 2 < WS_END) hsh = hsh * 31u + ((const unsigned short*)ws)[widx]; }
        dout[i] = (float)(hsh & 0xffffu);
    }
#endif
}

extern "C" void kernel_launch(void* const* d_in, const int* in_sizes, int n_in, void* d_out, int out_size, void* d_ws, size_t ws_size, hipStream_t stream) {
    static int grid = 0;
    if (grid == 0) {
        if (n_in != 16 || out_size != MTOK * DM || ws_size < WS_END) { fprintf(stderr, "kernel_launch: unexpected shapes (n_in %d, out %d, ws %zu)\n", n_in, out_size, ws_size); grid = -1; return; }
        int dev = 0, cus = 0, per_cu = 0;
        (void)hipGetDevice(&dev); (void)hipDeviceGetAttribute(&cus, hipDeviceAttributeMultiprocessorCount, dev);
        if (hipOccupancyMaxActiveBlocksPerMultiprocessor(&per_cu, (const void*)fwd_kernel, NTHREADS, 0) != hipSuccess || per_cu < 1) { fprintf(stderr, "kernel_launch: occupancy query gave %d\n", per_cu); per_cu = 1; }
        (void)hipGetLastError();
        grid = cus;
    }
    if (grid < 0) return;
    Args a{};
    for (int i = 0; i < 16; ++i) a.in[i] = (const float*)d_in[i];
    a.out = (float*)d_out; a.ws = (unsigned char*)d_ws;
    void* kargs[] = {&a};
#if MK_N_LAUNCHES == 1
#ifdef DIAG_PREFIX
    a.ph_lo = 0; a.ph_hi = DIAG_PREFIX + 1;
#else
    a.ph_lo = 0; a.ph_hi = NPH;
#endif
    hipError_t e = hipLaunchCooperativeKernel((const void*)fwd_kernel, dim3(grid), dim3(NTHREADS), kargs, 0, stream);
    if (e != hipSuccess) fprintf(stderr, "kernel_launch: cooperative launch failed: %s (grid %d)\n", hipGetErrorString(e), grid);
#else
    for (int ph = 0; ph < NPH; ++ph) {
        a.ph_lo = ph; a.ph_hi = ph + 1;
        hipError_t e = hipLaunchCooperativeKernel((const void*)fwd_kernel, dim3(grid), dim3(NTHREADS), kargs, 0, stream);
        if (e != hipSuccess) { fprintf(stderr, "kernel_launch: launch of phase %d failed: %s (grid %d)\n", ph, hipGetErrorString(e), grid); break; }
    }
#endif
}
```

```cpp
#include <hip/hip_runtime.h>
#include <hip/hip_cooperative_groups.h>
#include <cstdio>
#include <cstdint>
namespace cg = cooperative_groups;
namespace pg8 {
#define PG8_LAS __attribute__((address_space(3)))
typedef unsigned short bf16_t;
typedef short bf16x8 __attribute__((ext_vector_type(8)));
typedef float f32x4 __attribute__((ext_vector_type(4)));
typedef unsigned u32x4 __attribute__((ext_vector_type(4)));
constexpr int BM = 256, BK = 64, HALF = 128, HTB = HALF * BK * 2  , STAGE_BYTES = 8 * HTB, NXCD = 8, WGM = 8;

__host__ __device__ __forceinline__ int lds_byte(int r, int c) { const int st = (r >> 4) * 2 + (c >> 5), rr = r & 15, cc = c & 31, ob = rr * 64 + cc * 2; return st * 1024 + (ob ^ (((ob >> 9) & 1) << 5)); }
__host__ __device__ __forceinline__ void stage_rc(int b, int& R, int& C) { const int st = b / 1024, sb = b % 1024, swz = sb ^ (((sb >> 9) & 1) << 5); R = (st >> 1) * 16 + swz / 64; C = (st & 1) * 32 + (swz % 64) / 2; }
__host__ __device__ __forceinline__ int perm32(int rho) { const int n = rho >> 4, i = rho & 15; return 8 * (i >> 2) + 4 * n + (i & 3); }

struct Unit { int pm, pn; };
struct Gemm { const bf16_t* A; const bf16_t* Bt; int M, N, K; };

struct StaticOrder {
    int nM, nN, nwg, G, c;
    __host__ __device__ void init(int M, int N, int G_, int c_) { nM = M / BM; nN = N / BM; nwg = nM * nN; G = G_; c = c_; }
    __host__ __device__ bool next(int i, Unit& u) const {
        const long L = (long)i * G + c; if (L >= nwg) return false;
        int wgid = (int)L; { const int q = nwg / NXCD, r = nwg % NXCD, xcd = wgid % NXCD, off = wgid / NXCD; wgid = (xcd < r ? xcd * (q + 1) : r * (q + 1) + (xcd - r) * q) + off; }
        const int nig = WGM * nN, gid = wgid / nig, fm = gid * WGM, gsz = (nM - fm) < WGM ? (nM - fm) : WGM;
        u.pm = fm + ((wgid % nig) % gsz); u.pn = (wgid % nig) / gsz; return true;
    }
    __device__ __forceinline__ void a_ready(const Unit&) const {}
    __device__ __forceinline__ void done(const Unit&) const {}
};

typedef float f32x2_t __attribute__((ext_vector_type(2)));
typedef __bf16 bf16x2_t __attribute__((ext_vector_type(2)));
__device__ __forceinline__ unsigned cvt_pk_bf16(float lo, float hi) { f32x2_t v = {lo, hi}; bf16x2_t b = __builtin_convertvector(v, bf16x2_t); return __builtin_bit_cast(unsigned, b); }
template <class Epi, class Sched, bool ALIGN_EPI = false, bool SP2 = false>
__device__ __forceinline__ void gemm_phase(PG8_LAS unsigned char* lds, const Gemm g, const Sched& S, const Epi& E) {
    const int tid = threadIdx.x, wid = __builtin_amdgcn_readfirstlane(tid >> 6), lane = tid & 63, wr = wid >> 2, wc = wid & 3, fr = lane & 15, fq = lane >> 4;
    const int K = g.K, nt = K / BK;
    unsigned voffA[2], voffB[2];
#pragma unroll
    for (int i = 0; i < 2; ++i) { int R, C; stage_rc(tid * 16 + i * 8192, R, C); const int Rb = Epi::PERM ? ((R & ~31) + perm32(R & 31)) : R;
        voffA[i] = (unsigned)(R * K + C) * 2u; voffB[i] = (unsigned)(Rb * K + C) * 2u; }
    const size_t kstep = (size_t)(BK * 2);
    const size_t hstep = (size_t)HALF * K * 2;
    const size_t tstep = 2 * hstep;
    const unsigned ldsw = (unsigned)wid * 1024u;
    const int aoff = lds_byte(wr * 64 + fr, fq * 8), boff = lds_byte(wc * 32 + fr, fq * 8);
#define PG8_SA(b, h) (((b) * 2 + (h)) * HTB)
#define PG8_SB(b, h) ((4 + (b) * 2 + (h)) * HTB)
#define PG8_STAGE(bufoff, gbase, voff) do { _Pragma("unroll") for (int _i = 0; _i < 2; ++_i) \
        __builtin_amdgcn_global_load_lds((const unsigned*)((const char*)(gbase) + (voff)[_i]), (PG8_LAS unsigned*)(lds + (bufoff) + ldsw + _i * 8192), 16, 0, 0); } while (0)
#define PG8_LDA(dst, b, h) do { _Pragma("unroll") for (int m = 0; m < 4; ++m) _Pragma("unroll") for (int k = 0; k < 2; ++k) dst[m][k] = *(const PG8_LAS bf16x8*)(lds + PG8_SA(b, h) + aoff + m * 2048 + k * 1024); } while (0)
#define PG8_LDB(dst, b, h) do { _Pragma("unroll") for (int n = 0; n < 2; ++n) _Pragma("unroll") for (int k = 0; k < 2; ++k) dst[n][k] = *(const PG8_LAS bf16x8*)(lds + PG8_SB(b, h) + boff + n * 2048 + k * 1024); } while (0)
#define PG8_MMA(ai, bj, At, Bt) do { __builtin_amdgcn_s_setprio(1); _Pragma("unroll") for (int m = 0; m < 4; ++m) _Pragma("unroll") for (int n = 0; n < 2; ++n) _Pragma("unroll") for (int k = 0; k < 2; ++k) \
        acc[ai][bj][m][n] = __builtin_amdgcn_mfma_f32_16x16x32_bf16(Bt[n][k], At[m][k], acc[ai][bj][m][n], 0, 0, 0); __builtin_amdgcn_s_setprio(0); } while (0)
#define PG8_WAIT_V(n) asm volatile("s_waitcnt vmcnt(" #n ")" ::: "memory")
#define PG8_WAIT_L(n) asm volatile("s_waitcnt lgkmcnt(" #n ")" ::: "memory")
#define PG8_BAR __builtin_amdgcn_s_barrier()
#define PG8_SCHED __builtin_amdgcn_sched_barrier(0)
    Unit cur, nxt; int ui = 0;
    if (!S.next(0, cur)) return;
    f32x4 acc[2][2][4][2];
#pragma unroll
    for (int a = 0; a < 2; ++a)
#pragma unroll
        for (int b = 0; b < 2; ++b)
#pragma unroll
            for (int m = 0; m < 4; ++m)
#pragma unroll
                for (int n = 0; n < 2; ++n) acc[a][b][m][n] = (f32x4){0.f, 0.f, 0.f, 0.f};
    bf16x8 At[4][2], B0[2][2], B1[2][2];
    const char* cA = (const char*)g.A + (size_t)cur.pm * tstep; const char* cB = (const char*)g.Bt + (size_t)cur.pn * tstep;
    S.a_ready(cur);
    if constexpr (SP2) {
        PG8_STAGE(PG8_SB(0, 0), cB, voffB); PG8_STAGE(PG8_SB(0, 1), cB + hstep, voffB); PG8_STAGE(PG8_SA(0, 0), cA, voffA); PG8_STAGE(PG8_SA(0, 1), cA + hstep, voffA);
        if (wr == 1) PG8_BAR;
        PG8_WAIT_V(2); PG8_BAR;
        PG8_STAGE(PG8_SB(1, 0), cB + kstep, voffB); PG8_STAGE(PG8_SA(1, 0), cA + kstep, voffA); PG8_STAGE(PG8_SB(1, 1), cB + hstep + kstep, voffB);
        PG8_WAIT_V(6); PG8_BAR;
    } else {
        PG8_STAGE(PG8_SB(0, 0), cB, voffB); PG8_STAGE(PG8_SA(0, 0), cA, voffA); PG8_STAGE(PG8_SB(0, 1), cB + hstep, voffB); PG8_STAGE(PG8_SA(0, 1), cA + hstep, voffA);
        if (wr == 1) PG8_BAR;
        PG8_WAIT_V(4); PG8_BAR;
        PG8_STAGE(PG8_SB(1, 0), cB + kstep, voffB); PG8_STAGE(PG8_SA(1, 0), cA + kstep, voffA); PG8_STAGE(PG8_SB(1, 1), cB + hstep + kstep, voffB);
        PG8_WAIT_V(6); PG8_BAR;
    }
    for (;;) {
        const bool has_next = S.next(ui + 1, nxt);
        const char* nA = has_next ? (const char*)g.A + (size_t)nxt.pm * tstep : cA; const char* nB = has_next ? (const char*)g.Bt + (size_t)nxt.pn * tstep : cB;
        for (int t = 0; t < nt; t += 2) {
            const bool last = (t == nt - 2);
            const char* a1 = cA + (size_t)(t + 1) * kstep;
            const char* a2 = last ? nA : cA + (size_t)(t + 2) * kstep; const char* b2 = last ? nB : cB + (size_t)(t + 2) * kstep;
            const char* a3 = a2 + kstep; const char* b3 = b2 + kstep;
            if (last && has_next) S.a_ready(nxt);
            if constexpr (SP2) {
            PG8_LDB(B0, 0, 0); PG8_LDB(B1, 0, 1); PG8_SCHED; PG8_LDA(At, 0, 0); PG8_STAGE(PG8_SA(1, 1), a1 + hstep, voffA);
            PG8_WAIT_V(8); PG8_WAIT_L(0); PG8_BAR; PG8_MMA(0, 0, At, B0); PG8_MMA(0, 1, At, B1); PG8_BAR; PG8_SCHED;
            PG8_LDA(At, 0, 1); PG8_STAGE(PG8_SB(0, 0), b2, voffB); PG8_STAGE(PG8_SB(0, 1), b2 + hstep, voffB); PG8_STAGE(PG8_SA(0, 0), a2, voffA);
            PG8_WAIT_V(8); PG8_WAIT_L(0); PG8_BAR; PG8_MMA(1, 0, At, B0); PG8_MMA(1, 1, At, B1); PG8_BAR; PG8_SCHED;
            PG8_LDB(B0, 1, 0); PG8_LDB(B1, 1, 1); PG8_SCHED; PG8_LDA(At, 1, 0); PG8_STAGE(PG8_SA(0, 1), a2 + hstep, voffA);
            PG8_WAIT_V(8); PG8_WAIT_L(0); PG8_BAR; PG8_MMA(0, 0, At, B0); PG8_MMA(0, 1, At, B1); PG8_BAR; PG8_SCHED;
            PG8_LDA(At, 1, 1); PG8_STAGE(PG8_SB(1, 0), b3, voffB); PG8_STAGE(PG8_SB(1, 1), b3 + hstep, voffB); PG8_STAGE(PG8_SA(1, 0), a3, voffA);
            PG8_WAIT_V(8); PG8_WAIT_L(0); PG8_BAR; PG8_MMA(1, 0, At, B0); PG8_MMA(1, 1, At, B1); PG8_BAR; PG8_SCHED;
            } else {
            PG8_LDB(B0, 0, 0); PG8_SCHED; PG8_LDA(At, 0, 0); PG8_STAGE(PG8_SA(1, 1), a1 + hstep, voffA);
            PG8_WAIT_L(8); PG8_BAR; PG8_WAIT_L(0); PG8_MMA(0, 0, At, B0); PG8_BAR; PG8_SCHED;
            PG8_LDB(B1, 0, 1); PG8_STAGE(PG8_SB(0, 0), b2, voffB);
            PG8_BAR; PG8_WAIT_L(0); PG8_MMA(0, 1, At, B1); PG8_BAR;
            PG8_LDA(At, 0, 1); PG8_STAGE(PG8_SA(0, 0), a2, voffA);
            PG8_BAR; PG8_WAIT_L(0); PG8_MMA(1, 0, At, B0); PG8_BAR; PG8_SCHED;
            PG8_STAGE(PG8_SB(0, 1), b2 + hstep, voffB);
            PG8_WAIT_V(6); PG8_BAR; PG8_MMA(1, 1, At, B1); PG8_BAR;
            PG8_LDB(B0, 1, 0); PG8_SCHED; PG8_LDA(At, 1, 0); PG8_STAGE(PG8_SA(0, 1), a2 + hstep, voffA);
            PG8_WAIT_L(8); PG8_BAR; PG8_WAIT_L(0); PG8_MMA(0, 0, At, B0); PG8_BAR; PG8_SCHED;
            PG8_LDB(B1, 1, 1); PG8_STAGE(PG8_SB(1, 0), b3, voffB);
            PG8_BAR; PG8_WAIT_L(0); PG8_MMA(0, 1, At, B1); PG8_BAR;
            PG8_LDA(At, 1, 1); PG8_STAGE(PG8_SA(1, 0), a3, voffA);
            PG8_BAR; PG8_WAIT_L(0); PG8_MMA(1, 0, At, B0); PG8_BAR; PG8_SCHED;
            PG8_STAGE(PG8_SB(1, 1), b3 + hstep, voffB);
            PG8_WAIT_V(6); PG8_BAR; PG8_MMA(1, 1, At, B1); PG8_BAR;
            }
        }
        if constexpr (ALIGN_EPI) { if (wr == 0) PG8_BAR; }
        if constexpr (!Epi::AFTER_DRAIN) { E(acc, cur, wr, wc, fr, fq); S.done(cur); }
        if (!has_next) break;
#pragma unroll
        for (int a = 0; a < 2; ++a)
#pragma unroll
            for (int b = 0; b < 2; ++b)
#pragma unroll
                for (int m = 0; m < 4; ++m)
#pragma unroll
                    for (int n = 0; n < 2; ++n) acc[a][b][m][n] = (f32x4){0.f, 0.f, 0.f, 0.f};
        cur = nxt; cA = nA; cB = nB; ++ui;
        if constexpr (ALIGN_EPI) { if (wr == 1) PG8_BAR; }
    }
    PG8_WAIT_V(0);
    if constexpr (!ALIGN_EPI) { if (wr == 0) PG8_BAR; }
    PG8_BAR;
    if constexpr (Epi::AFTER_DRAIN) { E.fused(acc, cur, wr, wc, fr, fq, lds, wid, lane); S.done(cur); }
#undef PG8_SA
#undef PG8_SB
#undef PG8_STAGE
#undef PG8_LDA
#undef PG8_LDB
#undef PG8_MMA
#undef PG8_WAIT_V
#undef PG8_WAIT_L
#undef PG8_BAR
#undef PG8_SCHED
}
}

#ifndef MK_N_LAUNCHES
#define MK_N_LAUNCHES 1
#endif
#define LAS __attribute__((address_space(3)))
typedef unsigned short bf16_t;
typedef short bf16x8 __attribute__((ext_vector_type(8)));
typedef float f32x4 __attribute__((ext_vector_type(4)));
typedef unsigned u32x4 __attribute__((ext_vector_type(4)));
typedef unsigned u32x2 __attribute__((ext_vector_type(2)));
using pg8::cvt_pk_bf16;

constexpr int MTOK = 16384, DM = 2048, DFF = 8192, SEQ = 8192, NBATCH = 2, CHUNK = 64, NCHUNK = MTOK / CHUNK, CPB = SEQ / CHUNK;
constexpr float NEPS = 1e-6f;
constexpr int GLA_IN = 6160, GLA_NPAD = 6144;
constexpr size_t MiB = 1u << 20;
constexpr size_t WS_W = 0;
constexpr size_t W0IN = 0, W0OUT = 32 * MiB, W0UP = 40 * MiB, W0DN = 72 * MiB;
constexpr size_t W1IN = 0, W1OUT = 505 * MiB, W1UP = 40 * MiB, W1DN = 72 * MiB;
constexpr size_t WS_Q = 104 * MiB, WS_K0 = 168 * MiB, WS_K1 = 136 * MiB, WS_V = 232 * MiB, WS_G = 296 * MiB, WS_U = 104 * MiB;
constexpr size_t WS_A = 360 * MiB;
constexpr size_t WS_F = 424 * MiB;
constexpr size_t WS_AL = 488 * MiB, WS_BE = 490 * MiB, WS_GA = 492 * MiB;
constexpr size_t WS_SS = 494 * MiB;
constexpr size_t WS_R16 = 502 * MiB;
constexpr size_t WS_LB = 503 * MiB;
constexpr size_t WS_CTL = 504 * MiB, CTL_BYTES = 65536;
constexpr size_t WS_END = 513 * MiB;
constexpr int MISC_OFF = 147456 - 64;
constexpr int LDS_BYTES = 147456;
constexpr int NTHREADS = 512;

enum { PH_PRO = 0, PH_G1, PH_PREP0, PH_SCAN0, PH_HN0, PH_G2, PH_ROW0A, PH_G3, PH_G4, PH_ROW0B, PH_G5, PH_PREP1, PH_SCAN1, PH_HN1, PH_G6, PH_ROW1A, PH_G7, PH_G8, PH_ROW1B, NPH };
enum { E_PLAIN = 0, E_RELU2, E_HGRN_IN, E_GLA_IN };
enum { M_NONE = 0, M_SILU, M_RELU2, M_FGATE, M_R16 };

#define LDS_WAIT() asm volatile("s_waitcnt lgkmcnt(0)" ::: "memory")
#define LDS_BAR() do { asm volatile("s_waitcnt lgkmcnt(0)" ::: "memory"); __builtin_amdgcn_s_barrier(); asm volatile("" ::: "memory"); } while (0)

__device__ __forceinline__ float bf2f(unsigned short b) { return __uint_as_float(((unsigned)b) << 16); }
__device__ __forceinline__ float bflo(unsigned w) { return __uint_as_float(w << 16); }
__device__ __forceinline__ float bfhi(unsigned w) { return __uint_as_float(w & 0xffff0000u); }
__device__ __forceinline__ float wave_sum(float v) {
#pragma unroll
    for (int o = 1; o < 64; o <<= 1) v += __shfl_xor(v, o);
    return v;
}

template <int cfg> struct Epi {
    static constexpr bool PERM = true, AFTER_DRAIN = false;
    unsigned char* ws; float* dout;
    __device__ __forceinline__ void operator()(const f32x4 (&acc)[2][2][4][2], const pg8::Unit& u, int wr, int wc, int fr, int fq) const {
        const int row0 = u.pm * 256 + wr * 64 + fr;
        const int cin = wc * 32 + 8 * fq;
        int mode = M_NONE, ldo = DM, colt = u.pn * 256; float sc = 1.f; bf16_t* O = (bf16_t*)(ws + WS_F);
        if (cfg == E_RELU2) { mode = M_RELU2; O = (bf16_t*)(ws + WS_U); ldo = DFF; }
        else if (cfg == E_HGRN_IN) {
            const int seg = u.pn >> 3; colt = (u.pn & 7) * 256;
            if (seg == 0) { mode = M_SILU; O = (bf16_t*)(ws + WS_Q); }
            else if (seg == 1) { mode = M_FGATE; O = (bf16_t*)(ws + WS_K0); }
            else if (seg == 2) { O = (bf16_t*)(ws + WS_V); }
            else { O = (bf16_t*)(ws + WS_G); }
        } else if (cfg == E_GLA_IN) {
            if (u.pn < 4) { O = (bf16_t*)(ws + WS_Q); ldo = 1024; sc = 0.0625f; }
            else if (u.pn < 8) { O = (bf16_t*)(ws + WS_K1); ldo = 1024; colt = (u.pn - 4) * 256; }
            else if (u.pn < 16) { O = (bf16_t*)(ws + WS_V); colt = (u.pn - 8) * 256; }
            else if (u.pn < 24) { O = (bf16_t*)(ws + WS_G); colt = (u.pn - 16) * 256; }
            else { mode = M_R16; }
        }
        if (mode == M_FGATE) {
            const float* lb = (const float*)(ws + WS_LB);
#pragma unroll
            for (int bj = 0; bj < 2; ++bj) {
                const int col = colt + bj * 128 + cin;
                const f32x4 l0 = *(const f32x4*)(lb + col), l1 = *(const f32x4*)(lb + col + 4);
#pragma unroll
                for (int ai = 0; ai < 2; ++ai)
#pragma unroll
                    for (int m = 0; m < 4; ++m) {
                        const size_t row = (size_t)(row0 + ai * 128 + m * 16);
                        f32x4 k0, k1, f0, f1;
#pragma unroll
                        for (int j = 0; j < 4; ++j) {
                            const float a = acc[ai][bj][m][0][j], b = acc[ai][bj][m][1][j];
                            k0[j] = (1.f - l0[j]) * __builtin_amdgcn_rcpf(1.f + __expf(a)); k1[j] = (1.f - l1[j]) * __builtin_amdgcn_rcpf(1.f + __expf(b));
                            f0[j] = __logf(1.f - k0[j]); f1[j] = __logf(1.f - k1[j]);
                        }
                        u32x4 w; w.x = cvt_pk_bf16(k0[0], k0[1]); w.y = cvt_pk_bf16(k0[2], k0[3]); w.z = cvt_pk_bf16(k1[0], k1[1]); w.w = cvt_pk_bf16(k1[2], k1[3]);
                        *(u32x4*)(O + row * DM + col) = w;
                        *(f32x4*)(dout + row * DM + col) = f0; *(f32x4*)(dout + row * DM + col + 4) = f1;
                    }
            }
        } else if (mode == M_R16) {
            if (wc == 0 && fq < 2) {
                float* R = (float*)(ws + WS_R16);
#pragma unroll
                for (int ai = 0; ai < 2; ++ai)
#pragma unroll
                    for (int m = 0; m < 4; ++m) {
                        const size_t row = (size_t)(row0 + ai * 128 + m * 16);
                        *(f32x4*)(R + row * 16 + 8 * fq) = acc[ai][0][m][0]; *(f32x4*)(R + row * 16 + 8 * fq + 4) = acc[ai][0][m][1];
                    }
            }
        } else {
#pragma unroll
            for (int ai = 0; ai < 2; ++ai)
#pragma unroll
                for (int m = 0; m < 4; ++m) {
                    bf16_t* rowp = O + (size_t)(row0 + ai * 128 + m * 16) * ldo + colt + cin;
#pragma unroll
                    for (int bj = 0; bj < 2; ++bj) {
                        f32x4 v0 = acc[ai][bj][m][0], v1 = acc[ai][bj][m][1];
                        if (mode == M_SILU) {
#pragma unroll
                            for (int j = 0; j < 4; ++j) { v0[j] = v0[j] / (1.f + __expf(-v0[j])); v1[j] = v1[j] / (1.f + __expf(-v1[j])); }
                        } else if (mode == M_RELU2) {
#pragma unroll
                            for (int j = 0; j < 4; ++j) { const float a = fmaxf(v0[j], 0.f), b = fmaxf(v1[j], 0.f); v0[j] = a * a; v1[j] = b * b; }
                        } else { v0 = v0 * sc; v1 = v1 * sc; }
                        u32x4 w; w.x = cvt_pk_bf16(v0[0], v0[1]); w.y = cvt_pk_bf16(v0[2], v0[3]); w.z = cvt_pk_bf16(v1[0], v1[1]); w.w = cvt_pk_bf16(v1[2], v1[3]);
                        *(u32x4*)(rowp + bj * 128) = w;
                    }
                }
        }
    }
};

__device__ __forceinline__ void transpose_item(const float* W, int ldw, int nvalid, bf16_t* WT, int K, LAS float* scr, int kb, int nb, int lane) {
    const int k0 = 64 * kb, n0 = 64 * nb;
    const int kk = lane >> 4, n4 = (lane & 15) * 4;
    const bool ok = (n0 + n4) < nvalid;
    f32x4 v[16];
#pragma unroll
    for (int i = 0; i < 16; ++i) v[i] = ok ? *(const f32x4*)(W + (size_t)(k0 + 4 * i + kk) * ldw + n0 + n4) : (f32x4){0.f, 0.f, 0.f, 0.f};
#pragma unroll
    for (int i = 0; i < 16; ++i) { LAS float* d = scr + (4 * i + kk) * 65 + n4; d[0] = v[i][0]; d[1] = v[i][1]; d[2] = v[i][2]; d[3] = v[i][3]; }
    LDS_WAIT();
    const int c = lane & 7;
#pragma unroll
    for (int j = 0; j < 8; ++j) { const int nn = (lane >> 3) + 8 * j; const LAS float* s = scr + (8 * c) * 65 + nn;
        u32x4 o; o.x = cvt_pk_bf16(s[0 * 65], s[1 * 65]); o.y = cvt_pk_bf16(s[2 * 65], s[3 * 65]); o.z = cvt_pk_bf16(s[4 * 65], s[5 * 65]); o.w = cvt_pk_bf16(s[6 * 65], s[7 * 65]);
        *(u32x4*)(WT + (size_t)(n0 + nn) * K + k0 + 8 * c) = o; }
    LDS_WAIT();
}
__device__ __forceinline__ void convert_layer(LAS unsigned char* L, int gw, int ngw, int wave, int lane, int mask, const float* w_in, int ld_in, int nvalid_in, int nrows_in, const float* w_out, const float* w_up, const float* w_dn,
                                              bf16_t* t_in, bf16_t* t_out, bf16_t* t_up, bf16_t* t_dn) {
    LAS float* scr = (LAS float*)(L + wave * 16640);
    const int nb_in = nrows_in / 64;
    const int I_IN = (DM / 64) * nb_in, I_OUT = (DM / 64) * (DM / 64), I_UP = (DM / 64) * (DFF / 64), I_DN = (DFF / 64) * (DM / 64);
    const int lo_it = (mask & 1) ? 0 : (mask & 2) ? I_IN : (mask & 4) ? I_IN + I_OUT : I_IN + I_OUT + I_UP;
    const int hi_it = (mask & 8) ? I_IN + I_OUT + I_UP + I_DN : (mask & 4) ? I_IN + I_OUT + I_UP : (mask & 2) ? I_IN + I_OUT : I_IN;
    for (int it = lo_it + gw; it < hi_it; it += ngw) {
        int r = it;
        if (r < I_IN) { transpose_item(w_in, ld_in, nvalid_in, t_in, DM, scr, r / nb_in, r % nb_in, lane); continue; } r -= I_IN;
        if (r < I_OUT) { transpose_item(w_out, DM, DM, t_out, DM, scr, r / (DM / 64), r % (DM / 64), lane); continue; } r -= I_OUT;
        if (r < I_UP) { transpose_item(w_up, DFF, DFF, t_up, DM, scr, r / (DFF / 64), r % (DFF / 64), lane); continue; } r -= I_UP;
        transpose_item(w_dn, DM, DM, t_dn, DFF, scr, r / (DM / 64), r % (DM / 64), lane);
    }
}

__device__ __forceinline__ void row_pass(int gw, int ngw, int lane, const bf16_t* msrc, const float* hin, const float* wpost, float* hout, const float* wpre, bf16_t* hn, int row_end = MTOK) {
    for (int row = gw; row < row_end; row += ngw) {
        f32x4 h[4][2];
#pragma unroll
        for (int j = 0; j < 4; ++j) { const float* p = hin + (size_t)row * DM + j * 512 + lane * 8; h[j][0] = __builtin_nontemporal_load((const f32x4*)p); h[j][1] = __builtin_nontemporal_load((const f32x4*)(p + 4)); }
        if (msrc) {
            f32x4 mv[4][2]; float ss = 0.f;
#pragma unroll
            for (int j = 0; j < 4; ++j) { const u32x4 w = __builtin_nontemporal_load((const u32x4*)(msrc + (size_t)row * DM + j * 512 + lane * 8));
                mv[j][0] = (f32x4){bflo(w.x), bfhi(w.x), bflo(w.y), bfhi(w.y)}; mv[j][1] = (f32x4){bflo(w.z), bfhi(w.z), bflo(w.w), bfhi(w.w)};
#pragma unroll
                for (int q = 0; q < 4; ++q) ss += mv[j][0][q] * mv[j][0][q] + mv[j][1][q] * mv[j][1][q]; }
            const float rstd = rsqrtf(wave_sum(ss) * (1.f / DM) + NEPS);
#pragma unroll
            for (int j = 0; j < 4; ++j) { const float* wp = wpost + j * 512 + lane * 8; const f32x4 w0 = *(const f32x4*)wp, w1 = *(const f32x4*)(wp + 4);
                h[j][0] = h[j][0] + mv[j][0] * rstd * w0; h[j][1] = h[j][1] + mv[j][1] * rstd * w1;
                float* op = hout + (size_t)row * DM + j * 512 + lane * 8; __builtin_nontemporal_store(h[j][0], (f32x4*)op); __builtin_nontemporal_store(h[j][1], (f32x4*)(op + 4)); }
        }
        if (wpre) {
            float ss = 0.f;
#pragma unroll
            for (int j = 0; j < 4; ++j)
#pragma unroll
                for (int q = 0; q < 4; ++q) ss += h[j][0][q] * h[j][0][q] + h[j][1][q] * h[j][1][q];
            const float rstd = rsqrtf(wave_sum(ss) * (1.f / DM) + NEPS);
#pragma unroll
            for (int j = 0; j < 4; ++j) { const float* wp = wpre + j * 512 + lane * 8; const f32x4 w0 = *(const f32x4*)wp, w1 = *(const f32x4*)(wp + 4);
                const f32x4 a = h[j][0] * rstd * w0, b = h[j][1] * rstd * w1;
                u32x4 o; o.x = cvt_pk_bf16(a[0], a[1]); o.y = cvt_pk_bf16(a[2], a[3]); o.z = cvt_pk_bf16(b[0], b[1]); o.w = cvt_pk_bf16(b[2], b[3]);
                *(u32x4*)(hn + (size_t)row * DM + j * 512 + lane * 8) = o; }
        }
    }
}

template <int DK, int DV, int H, bool GLA>
__device__ __forceinline__ void prep_phase(LAS unsigned char* L, int tid, bf16_t* Q, const bf16_t* Kin, const float* LF, const float* R16, const float* wgk, const float* bgk,
                                           bf16_t* V, bf16_t* Ktt, float* GA, bf16_t* OI) {
    constexpr int DKT = DK * H, DVT = DV * H, NCP = DK / 2, NSEG = NTHREADS / NCP, SEGL = 64 / NSEG, QSTR = DK + 8, PSTR = 72, DVC = (DV > 256) ? 256 : DV, NDVC = DV / DVC, EPRC = DVC / 64;
    constexpr int VIT = (64 * DVC / 8) / NTHREADS;
    constexpr int OFF_QS = 0, OFF_KS = 64 * QSTR * 2, OFF_P = 2 * 64 * QSTR * 2, OFF_VT = OFF_P + 64 * PSTR * 2, OFF_SEG = OFF_VT + DVC * PSTR * 2;
    static_assert(OFF_SEG + NSEG * DK * 4 <= 131072, "prep LDS");
    LAS bf16_t* Qs = (LAS bf16_t*)(L + OFF_QS); LAS bf16_t* Ks = (LAS bf16_t*)(L + OFF_KS); LAS bf16_t* Ps = (LAS bf16_t*)(L + OFF_P); LAS bf16_t* Vt = (LAS bf16_t*)(L + OFF_VT);
    LAS float* segsum = (LAS float*)(L + OFF_SEG);
    const int lane = tid & 63, wid = __builtin_amdgcn_readfirstlane(tid >> 6), fr = lane & 15, fg = lane >> 4;
    const int cp = tid % NCP, seg = __builtin_amdgcn_readfirstlane(tid / NCP), col = 2 * cp;
    typedef float f32x2v __attribute__((ext_vector_type(2)));
#define PREP_LOAD(tile_, qw_, kw_, vreg_, g0_, g1_) do { const int h_ = (tile_) % H, tk0_ = ((tile_) / H) * CHUNK; \
        _Pragma("unroll") for (int i = 0; i < SEGL; ++i) { const size_t ru = (size_t)(tk0_ + seg * SEGL + i) * DKT + h_ * DK; \
            qw_[i] = *(const unsigned*)(Q + ru + col); kw_[i] = *(const unsigned*)(Kin + ru + col); \
            const f32x2v v_ = *(const f32x2v*)(LF + ru + col); g0_[i] = v_.x; g1_[i] = v_.y; } \
        _Pragma("unroll") for (int itx = 0; itx < VIT; ++itx) { const int item = itx * NTHREADS + tid, tok = item & 63, e8 = item >> 6; \
            vreg_[itx] = *(const u32x4*)(V + (size_t)(tk0_ + tok) * DVT + h_ * DV + e8 * 8); } } while (0)
    unsigned qwn[SEGL], kwn[SEGL]; u32x4 vregn[VIT]; float g0n[SEGL], g1n[SEGL];
    if (!GLA) { if ((int)blockIdx.x < NCHUNK * H) PREP_LOAD((int)blockIdx.x, qwn, kwn, vregn, g0n, g1n); }
    for (int tile = blockIdx.x; tile < NCHUNK * H; tile += gridDim.x) {
        const int h = tile % H, cgi = tile / H, token0 = cgi * CHUNK, gcol = h * DK + col;
        unsigned qw[SEGL], kw[SEGL]; u32x4 vreg[VIT]; float g0[SEGL], g1[SEGL];
        if (GLA) {
#pragma unroll
            for (int itx = 0; itx < VIT; ++itx) { const int item = itx * NTHREADS + tid, tok = item & 63, e8 = item >> 6;
                vreg[itx] = *(const u32x4*)(V + (size_t)(token0 + tok) * DVT + h * DV + e8 * 8); }
            float wk0[16], wk1[16];
#pragma unroll
            for (int r = 0; r < 16; ++r) { const f32x2v w = *(const f32x2v*)(wgk + r * DKT + gcol); wk0[r] = w.x; wk1[r] = w.y; }
            const f32x2v bk = *(const f32x2v*)(bgk + gcol);
#pragma unroll
            for (int i = 0; i < SEGL; ++i) {
                const float* rp = R16 + (size_t)(token0 + seg * SEGL + i) * 16;
                float z0 = bk.x, z1 = bk.y;
#pragma unroll
                for (int r = 0; r < 16; ++r) { const float rv = rp[r]; z0 += rv * wk0[r]; z1 += rv * wk1[r]; }
                g0[i] = (fminf(z0, 0.f) - __logf(1.f + __expf(-fabsf(z0)))) * 0.0625f; g1[i] = (fminf(z1, 0.f) - __logf(1.f + __expf(-fabsf(z1)))) * 0.0625f;
                if ((i & 3) == 3) asm volatile("" ::: "memory");
            }
        } else {
#pragma unroll
            for (int i = 0; i < SEGL; ++i) { qw[i] = qwn[i]; kw[i] = kwn[i]; g0[i] = g0n[i]; g1[i] = g1n[i]; }
#pragma unroll
            for (int itx = 0; itx < VIT; ++itx) vreg[itx] = vregn[itx];
            if (tile + (int)gridDim.x < NCHUNK * H) PREP_LOAD(tile + (int)gridDim.x, qwn, kwn, vregn, g0n, g1n);
        }
#pragma unroll
        for (int i = 1; i < SEGL; ++i) { g0[i] += g0[i - 1]; g1[i] += g1[i - 1]; }
        *(LAS f32x2v*)(segsum + seg * DK + col) = (f32x2v){g0[SEGL - 1], g1[SEGL - 1]};
        LDS_BAR();
        float pre0 = 0.f, pre1 = 0.f, bref0 = 0.f, bref1 = 0.f, bl0 = 0.f, bl1 = 0.f;
#pragma unroll
        for (int s = 0; s < NSEG; ++s) { const f32x2v v = *(const LAS f32x2v*)(segsum + s * DK + col); if (s < seg) { pre0 += v.x; pre1 += v.y; } if (s < NSEG / 2) { bref0 += v.x; bref1 += v.y; } bl0 += v.x; bl1 += v.y; }
        if (seg == 0) *(f32x2v*)(GA + (size_t)cgi * DKT + gcol) = (f32x2v){__expf(bl0), __expf(bl1)};
        const float ea0 = __expf(bref0), ea1 = __expf(bref1), eb0 = __expf(bl0 - bref0), eb1 = __expf(bl1 - bref1);
        if (GLA) {
#pragma unroll
            for (int i = 0; i < SEGL; ++i) { const size_t ru = (size_t)(token0 + seg * SEGL + i) * DKT + h * DK; qw[i] = *(const unsigned*)(Q + ru + col); kw[i] = *(const unsigned*)(Kin + ru + col); }
        }
        float kh0[SEGL], kh1[SEGL]; unsigned qh[SEGL];
#pragma unroll
        for (int i = 0; i < SEGL; ++i) {
            const int tok = seg * SEGL + i;
            const float d0 = g0[i] + pre0 - bref0, d1 = g1[i] + pre1 - bref1;
            const float qt0 = bflo(qw[i]) * __expf(d0), qt1 = bfhi(qw[i]) * __expf(d1), kt0 = bflo(kw[i]) * __expf(-d0), kt1 = bfhi(kw[i]) * __expf(-d1);
            *(LAS unsigned*)(Qs + tok * QSTR + col) = cvt_pk_bf16(qt0, qt1);
            *(LAS unsigned*)(Ks + tok * QSTR + col) = cvt_pk_bf16(kt0, kt1);
            qh[i] = cvt_pk_bf16(qt0 * ea0, qt1 * ea1);
            kh0[i] = kt0 * eb0; kh1[i] = kt1 * eb1;
        }
#pragma unroll
        for (int i = 0; i < SEGL; i += 8) {
            u32x4 w0, w1;
            w0.x = cvt_pk_bf16(kh0[i], kh0[i + 1]); w0.y = cvt_pk_bf16(kh0[i + 2], kh0[i + 3]); w0.z = cvt_pk_bf16(kh0[i + 4], kh0[i + 5]); w0.w = cvt_pk_bf16(kh0[i + 6], kh0[i + 7]);
            w1.x = cvt_pk_bf16(kh1[i], kh1[i + 1]); w1.y = cvt_pk_bf16(kh1[i + 2], kh1[i + 3]); w1.z = cvt_pk_bf16(kh1[i + 4], kh1[i + 5]); w1.w = cvt_pk_bf16(kh1[i + 6], kh1[i + 7]);
            { const int tk = seg * SEGL + i; const size_t kb = (((size_t)cgi * (DKT / 16) + (gcol >> 4)) * 2 + (tk >> 5)) * 512 + (((tk & 31) >> 3) * 16) * 8;
              *(u32x4*)(Ktt + kb + (gcol & 15) * 8) = w0; *(u32x4*)(Ktt + kb + ((gcol + 1) & 15) * 8) = w1; }
        }
        LDS_BAR();
#pragma unroll
        for (int i = 0; i < SEGL; ++i) { const int tok = seg * SEGL + i; const int o = (((tok >> 4) * (DK / 32) + (col >> 5)) * 512) + ((((col & 31) >> 3) * 16 + (tok & 15)) * 8) + (col & 7);
            *(unsigned*)((bf16_t*)Q + ((size_t)(token0 + o / DK) * DKT + h * DK) + (o % DK)) = qh[i]; }
        {
            const int it = wid >> 1;
#pragma unroll
            for (int jj = 0; jj < 2; ++jj) {
                const int jt = 2 * (wid & 1) + jj;
                f32x4 acc = {0.f, 0.f, 0.f, 0.f};
                if (jt <= it) {
#pragma unroll
                    for (int ks = 0; ks < DK / 32; ++ks) {
                        const bf16x8 a = *(const LAS bf16x8*)(Ks + (jt * 16 + fr) * QSTR + ks * 32 + fg * 8);
                        const bf16x8 b = *(const LAS bf16x8*)(Qs + (it * 16 + fr) * QSTR + ks * 32 + fg * 8);
                        acc = __builtin_amdgcn_mfma_f32_16x16x32_bf16(a, b, acc, 0, 0, 0);
                    }
                    if (jt == it) {
#pragma unroll
                        for (int r = 0; r < 4; ++r) if (4 * fg + r > fr) acc[r] = 0.f;
                    }
                }
                u32x2 w; w.x = cvt_pk_bf16(acc[0], acc[1]); w.y = cvt_pk_bf16(acc[2], acc[3]);
                *(LAS u32x2*)(Ps + (it * 16 + fr) * PSTR + jt * 16 + 4 * fg) = w;
            }
        }
#pragma unroll
        for (int dc = 0; dc < NDVC; ++dc) {
            const int e0 = dc * DVC;
#pragma unroll
            for (int itx = 0; itx < VIT; ++itx) {
                const int item = itx * NTHREADS + tid, tok = item & 63, e8 = item >> 6;
                const u32x4 w = vreg[itx];
#pragma unroll
                for (int q = 0; q < 4; ++q) { Vt[(e8 * 8 + 2 * q) * PSTR + tok] = (unsigned short)(w[q] & 0xffffu); Vt[(e8 * 8 + 2 * q + 1) * PSTR + tok] = (unsigned short)(w[q] >> 16); }
                if (dc + 1 < NDVC) vreg[itx] = *(const u32x4*)(V + (size_t)(token0 + tok) * DVT + h * DV + (dc + 1) * DVC + e8 * 8);
            }
            LDS_BAR();
            const int it = wid & 3;
            const bf16x8 p0 = *(const LAS bf16x8*)(Ps + (it * 16 + fr) * PSTR + fg * 8), p1 = *(const LAS bf16x8*)(Ps + (it * 16 + fr) * PSTR + 32 + fg * 8);
#pragma unroll
            for (int k = 0; k < DVC / 32; ++k) {
                const int et = (wid >> 2) + 2 * k;
                const bf16x8 a0 = *(const LAS bf16x8*)(Vt + (et * 16 + fr) * PSTR + fg * 8), a1 = *(const LAS bf16x8*)(Vt + (et * 16 + fr) * PSTR + 32 + fg * 8);
                f32x4 acc = {0.f, 0.f, 0.f, 0.f};
                acc = __builtin_amdgcn_mfma_f32_16x16x32_bf16(a0, p0, acc, 0, 0, 0);
                acc = __builtin_amdgcn_mfma_f32_16x16x32_bf16(a1, p1, acc, 0, 0, 0);
                u32x2 w; w.x = cvt_pk_bf16(acc[0], acc[1]); w.y = cvt_pk_bf16(acc[2], acc[3]);
                *(u32x2*)(OI + ((((size_t)cgi * H + h) * (DV / 16) + (e0 >> 4) + et) * 64 + it * 16 + fr) * 16 + 4 * fg) = w;
            }
#pragma unroll
            for (int itx = 0; itx < VIT; ++itx) {
                const int item = itx * NTHREADS + tid, t8 = item & 7, e = item >> 3;
                const u32x4 w = *(const LAS u32x4*)(Vt + e * PSTR + t8 * 8);
                { const int o = (((e >> 4) * 2 + (t8 >> 2)) * 512) + (((t8 & 3) * 16 + (e & 15)) * 8);
                  *(u32x4*)(V + (size_t)(token0 + o / DVC) * DVT + h * DV + e0 + (o % DVC)) = w; }
            }
            LDS_BAR();
        }
    }
}

#undef PREP_LOAD
template <int DK, int DV, int H, int NS, int UNR, int NE>
__device__ __forceinline__ void scan_phase(LAS unsigned char* L, int tid, const bf16_t* Qh, const bf16_t* Ktt, const bf16_t* Vtp, bf16_t* OI, const float* GA, float* SS, unsigned* dummy, unsigned* grp) {
    constexpr int DKT = DK * H, DVT = DV * H, NSL = DV / 16, NSLB = NSL / NE, TPW = DK / 128, NKS = DK / 32, SSTR = DK + 8, DVC = (DV > 256) ? 256 : DV, EPRC = DVC / 64, NBH = NBATCH * H;
    static_assert(UNR % NS == 0 && NSL % NE == 0, "scan geometry");
    LAS bf16_t* St = (LAS bf16_t*)L;
    const int lane = tid & 63, wid = __builtin_amdgcn_readfirstlane(tid >> 6), fr = lane & 15, fg = lane >> 4;
    for (int item = blockIdx.x; item < NBH * NSLB; item += gridDim.x) {
        const int xc = item & 7, jx = item >> 3, bh = xc + 8 * (jx / NSLB), slb = jx % NSLB;
        const int b = bh / H, h = bh % H, ecol0 = h * DV + slb * 16 * NE;
        f32x4 S[TPW][NE];
#pragma unroll
        for (int t = 0; t < TPW; ++t)
#pragma unroll
            for (int j = 0; j < NE; ++j) S[t][j] = (f32x4){0.f, 0.f, 0.f, 0.f};
        bf16x8 kf[NS][TPW][2], qf[NS][NKS], vf[NS][NE][2]; f32x4 ga[NS][TPW]; u32x2 oi[NS][NE];
        constexpr int LPB = 2 * DK / NSLB, TD = NS + 2;
        static_assert(LPB <= 64, "scan geometry");
        constexpr bool TOUCH = false;
        unsigned tch[3] = {0u, 0u, 0u}, tacc = 0u;
        const int tli = slb * LPB + lane;
#define SCAN_LOAD(c, s) do { const int cgi_ = b * CPB + (c); const int tk0_ = cgi_ * CHUNK; \
        _Pragma("unroll") for (int t = 0; t < TPW; ++t) { const size_t d_ = (size_t)cgi_ * DKT + h * DK + (wid * TPW + t) * 16; \
            { const bf16_t* kp_ = Ktt + (((size_t)cgi_ * (DKT / 16) + (h * DK) / 16 + wid * TPW + t) * 2) * 512 + lane * 8; kf[s][t][0] = *(const bf16x8*)kp_; kf[s][t][1] = *(const bf16x8*)(kp_ + 512); } \
            ga[s][t] = *(const f32x4*)(GA + d_ + 4 * fg); } \
        _Pragma("unroll") for (int j = 0; j < NE; ++j) { const int ev_ = (slb * NE + j) * 16; \
            const int o0_ = (((ev_ % DVC) >> 4) * 2) * 512 + lane * 8, o1_ = o0_ + 512; const bf16_t* vb_ = Vtp + (size_t)tk0_ * DVT + h * DV + (ev_ / DVC) * DVC; \
            vf[s][j][0] = *(const bf16x8*)(vb_ + (size_t)(o0_ / DVC) * DVT + (o0_ % DVC)); vf[s][j][1] = *(const bf16x8*)(vb_ + (size_t)(o1_ / DVC) * DVT + (o1_ % DVC)); } \
        if (wid < 4) { _Pragma("unroll") for (int ks = 0; ks < NKS; ++ks) { const int o_ = (wid * NKS + ks) * 512 + lane * 8; qf[s][ks] = *(const bf16x8*)(Qh + (size_t)(tk0_ + o_ / DK) * DKT + h * DK + (o_ % DK)); } \
            _Pragma("unroll") for (int j = 0; j < NE; ++j) oi[s][j] = *(const u32x2*)(OI + ((((size_t)cgi_ * H + h) * NSL + slb * NE + j) * 64 + wid * 16 + fr) * 16 + 4 * fg); } } while (0)
#pragma unroll
        for (int s = 0; s < NS - 1; ++s) SCAN_LOAD(s, s);
#ifdef EXP_NOLOAD
        SCAN_LOAD(0, NS - 1);
#endif
#pragma unroll 1
        for (int c0 = 0; c0 < CPB; c0 += UNR) {
#pragma unroll
            for (int u = 0; u < UNR; ++u) {
                const int s = u % NS;
                const int c = c0 + u;
                if (CPB % UNR == 0 || c < CPB) {
#ifndef EXP_NOLOAD
                    { const int cl = (c + NS - 1 < CPB) ? c + NS - 1 : CPB - 1; SCAN_LOAD(cl, (u + NS - 1) % NS); }
#endif
                    if (TOUCH && wid == 7) { tacc ^= tch[u % 3];
                        if (lane < LPB) { const int ct = (c + TD < CPB) ? c + TD : CPB - 1; const int cgt = b * CPB + ct;
                            const bf16_t* tp = (tli < DK) ? Ktt + ((size_t)cgt * DKT + h * DK + tli) * 64
                                                          : Qh + (size_t)(cgt * CHUNK + (tli - DK) / (DK / 64)) * DKT + h * DK + ((tli - DK) % (DK / 64)) * 64;
                            tch[u % 3] = *(const unsigned*)tp; } }
                    const int token0 = (b * CPB + c) * CHUNK;
                    LAS bf16_t* Sb = St + (c & 1) * (16 * NE) * SSTR;
                    f32x4 dS[TPW][NE];
#pragma unroll
                    for (int t = 0; t < TPW; ++t)
#pragma unroll
                        for (int j = 0; j < NE; ++j) { dS[t][j] = (f32x4){0.f, 0.f, 0.f, 0.f};
                            dS[t][j] = __builtin_amdgcn_mfma_f32_16x16x32_bf16(kf[s][t][0], vf[s][j][0], dS[t][j], 0, 0, 0); dS[t][j] = __builtin_amdgcn_mfma_f32_16x16x32_bf16(kf[s][t][1], vf[s][j][1], dS[t][j], 0, 0, 0); }
#pragma unroll
                    for (int t = 0; t < TPW; ++t)
#pragma unroll
                        for (int j = 0; j < NE; ++j) { u32x2 w; w.x = cvt_pk_bf16(S[t][j][0], S[t][j][1]); w.y = cvt_pk_bf16(S[t][j][2], S[t][j][3]);
                            *(LAS u32x2*)(Sb + (j * 16 + fr) * SSTR + (wid * TPW + t) * 16 + 4 * fg) = w; }
#pragma unroll
                    for (int t = 0; t < TPW; ++t)
#pragma unroll
                        for (int j = 0; j < NE; ++j) S[t][j] = ga[s][t] * S[t][j] + dS[t][j];
                    LDS_BAR();
                    if (wid < 4) {
                        const size_t tok = (size_t)(token0 + wid * 16 + fr);
#pragma unroll
                        for (int j = 0; j < NE; ++j) {
                            f32x4 acc = {0.f, 0.f, 0.f, 0.f}, acc2 = {0.f, 0.f, 0.f, 0.f};
#pragma unroll
                            for (int ks = 0; ks < NKS; ks += 2) { const bf16x8 a = *(const LAS bf16x8*)(Sb + (j * 16 + fr) * SSTR + ks * 32 + fg * 8), a2 = *(const LAS bf16x8*)(Sb + (j * 16 + fr) * SSTR + (ks + 1) * 32 + fg * 8);
                                acc = __builtin_amdgcn_mfma_f32_16x16x32_bf16(a, qf[s][ks], acc, 0, 0, 0); acc2 = __builtin_amdgcn_mfma_f32_16x16x32_bf16(a2, qf[s][ks + 1], acc2, 0, 0, 0); }
                            acc = acc + acc2;
                            acc[0] += bflo(oi[s][j].x); acc[1] += bfhi(oi[s][j].x); acc[2] += bflo(oi[s][j].y); acc[3] += bfhi(oi[s][j].y);
                            u32x2 w; w.x = cvt_pk_bf16(acc[0], acc[1]); w.y = cvt_pk_bf16(acc[2], acc[3]);
                            *(u32x2*)(OI + ((((size_t)(b * CPB + c) * H + h) * NSL + slb * NE + j) * 64 + wid * 16 + fr) * 16 + 4 * fg) = w;
                        }
                    }
                }
            }
        }
#undef SCAN_LOAD
        if (TOUCH && wid == 7) dummy[blockIdx.x * 64 + lane] = tacc ^ tch[0] ^ tch[1] ^ tch[2];
        LDS_BAR();
    }
}

__device__ __forceinline__ void r_load_w(LAS unsigned char* L, int tid, const float* w_in1) {
    LAS bf16_t* wT = (LAS bf16_t*)L;
#pragma unroll
    for (int it = 0; it < 4; ++it) { const int k = it * NTHREADS + tid; const float* p = w_in1 + (size_t)k * GLA_IN + 6144;
#pragma unroll
        for (int q4 = 0; q4 < 4; ++q4) { const f32x4 v = *(const f32x4*)(p + 4 * q4);
#pragma unroll
            for (int q = 0; q < 4; ++q) wT[(4 * q4 + q) * 2056 + k] = (unsigned short)(cvt_pk_bf16(v[q], v[q]) & 0xffffu); } }
}
__device__ __forceinline__ void r_block(LAS unsigned char* L, int tid, int rb, const bf16_t* hn, float* R16) {
    const LAS bf16_t* wT = (const LAS bf16_t*)L;
    const int lane = tid & 63, wid = __builtin_amdgcn_readfirstlane(tid >> 6), fr = lane & 15, fg = lane >> 4;
    if (wid < 4) {
        const bf16_t* ap = hn + (size_t)(rb * 64 + wid * 16 + fr) * DM + fg * 8;
        f32x4 acc = {0.f, 0.f, 0.f, 0.f}, acc2 = {0.f, 0.f, 0.f, 0.f};
#pragma unroll 4
        for (int ks = 0; ks < DM / 32; ks += 2) {
            const bf16x8 b0 = *(const bf16x8*)(ap + ks * 32), b1 = *(const bf16x8*)(ap + ks * 32 + 32);
            const bf16x8 a0 = *(const LAS bf16x8*)(wT + fr * 2056 + ks * 32 + fg * 8), a1 = *(const LAS bf16x8*)(wT + fr * 2056 + ks * 32 + 32 + fg * 8);
            acc = __builtin_amdgcn_mfma_f32_16x16x32_bf16(a0, b0, acc, 0, 0, 0); acc2 = __builtin_amdgcn_mfma_f32_16x16x32_bf16(a1, b1, acc2, 0, 0, 0);
        }
        acc = acc + acc2;
        *(f32x4*)(R16 + (size_t)(rb * 64 + wid * 16 + fr) * 16 + 4 * fg) = acc;
    }
}

template <int DV, int H>
__device__ __forceinline__ void hn_phase(int gtid, int ngt, const bf16_t* OI, const bf16_t* G, const float* gain, bf16_t* A) {
    for (int i = gtid; i < MTOK * (DM / 8); i += ngt) {
        const int token = i >> 8, col = (i & 255) * 8, head = col / DV;
        const int e_ = col % DV;
        const u32x4 ow = *(const u32x4*)(OI + ((((size_t)(token >> 6) * H + head) * (DV / 16) + (e_ >> 4)) * 64 + (token & 63)) * 16 + (e_ & 15)), gw = *(const u32x4*)(G + (size_t)token * DM + col);
        const f32x4 g0 = *(const f32x4*)(gain + (col % DV)), g1 = *(const f32x4*)(gain + (col % DV) + 4);
        float o[8] = {bflo(ow.x), bfhi(ow.x), bflo(ow.y), bfhi(ow.y), bflo(ow.z), bfhi(ow.z), bflo(ow.w), bfhi(ow.w)};
        float ss = 0.f;
#pragma unroll
        for (int q = 0; q < 8; ++q) ss += o[q] * o[q];
#pragma unroll
        for (int m = 1; m < DV / 8; m <<= 1) ss += __shfl_xor(ss, m);
        const float rstd = rsqrtf(ss * (1.f / DV) + NEPS);
        float gt[8] = {bflo(gw.x), bfhi(gw.x), bflo(gw.y), bfhi(gw.y), bflo(gw.z), bfhi(gw.z), bflo(gw.w), bfhi(gw.w)};
        float r[8];
#pragma unroll
        for (int q = 0; q < 8; ++q) { const float gn = (q < 4) ? g0[q & 3] : g1[q & 3]; r[q] = o[q] * rstd * gn * (gt[q] / (1.f + __expf(-gt[q]))); }
        u32x4 w; w.x = cvt_pk_bf16(r[0], r[1]); w.y = cvt_pk_bf16(r[2], r[3]); w.z = cvt_pk_bf16(r[4], r[5]); w.w = cvt_pk_bf16(r[6], r[7]);
        *(u32x4*)(A + (size_t)token * DM + col) = w;
    }
}

#define XB_TMO      128
#define XB_XCNT(j)  (256  + 64 * (j))
#define XB_XSUB(j)  (1280 + 64 * (j))
#define XB_XGEN(j)  (2304 + 64 * (j))
#define XB_TOP      3328
#define XB_TOPGEN   3392
#define XCD_BAR_WORDS 3456
#define XB_SPIN_CAP (1u << 18)

__device__ __forceinline__ unsigned xb_ld(unsigned* p)              { return __hip_atomic_load(p, __ATOMIC_RELAXED, __HIP_MEMORY_SCOPE_AGENT); }
__device__ __forceinline__ unsigned xb_add(unsigned* p, unsigned v) { return __hip_atomic_fetch_add(p, v, __ATOMIC_RELAXED, __HIP_MEMORY_SCOPE_AGENT); }
__device__ __forceinline__ unsigned xb_xcc_id() { return (unsigned)__builtin_amdgcn_s_getreg((3 << 11) | 20) & 0xFu; }
#define XB_SPIN(cond, bar) do { unsigned _sp = 0; while (cond) { __builtin_amdgcn_s_sleep(1); \
    if ((++_sp & 255u) == 0u) { if (xb_ld(&(bar)[XB_TMO])) break; if (_sp > XB_SPIN_CAP) { atomicAdd(&(bar)[XB_TMO], 1u); break; } } } } while (0)

struct XcdBarrier {
    unsigned* bar; unsigned x;
    volatile LAS unsigned* st;
};

__device__ __forceinline__ XcdBarrier xcd_barrier_post(unsigned* bar, volatile LAS unsigned* st) {
    XcdBarrier b; b.bar = bar; b.x = xb_xcc_id(); b.st = st;
    if (threadIdx.x == 0) (void)xb_add(&bar[XB_XCNT(b.x)], 1u);
    return b;
}
__device__ __forceinline__ void xcd_barrier_complete(unsigned* bar, unsigned x, unsigned& nloc, unsigned& nx) {
    const unsigned G = gridDim.x * gridDim.y * gridDim.z;
    unsigned sum, cnt, mine, sp = 0u;
    for (;;) {
        sum = 0u; cnt = 0u; mine = 0u;
#pragma unroll
        for (unsigned j = 0; j < 16; ++j) { const unsigned c = xb_ld(&bar[XB_XCNT(j)]); sum += c; cnt += (c > 0u) ? 1u : 0u; mine = (j == x) ? c : mine; }
        if (sum == G) break;
        __builtin_amdgcn_s_sleep(1);
        if ((++sp & 255u) == 0u) { if (xb_ld(&bar[XB_TMO])) break; if (sp > XB_SPIN_CAP) { atomicAdd(&bar[XB_TMO], 1u); break; } }
    }
    nloc = mine > 0u ? mine : 1u; nx = cnt > 0u ? cnt : 1u;
}

__device__ __forceinline__ void xcd_barrier(const XcdBarrier& b) {
    asm volatile("s_waitcnt vmcnt(0)" ::: "memory");
    __syncthreads();
    if (threadIdx.x == 0) {
        unsigned* bar = b.bar;
        __builtin_amdgcn_s_waitcnt(0);
        unsigned nloc = b.st[0], nx = b.st[1];
        if (nloc == 0u) { xcd_barrier_complete(bar, b.x, nloc, nx); b.st[0] = nloc; b.st[1] = nx; }
        const unsigned old = xb_add(&bar[XB_XSUB(b.x)], 1u);
        const unsigned gen = old / nloc;
        if (old + 1u == (gen + 1u) * nloc) {
            __builtin_amdgcn_fence(__ATOMIC_RELEASE, "agent");
            asm volatile("s_waitcnt vmcnt(0)" ::: "memory");
            const unsigned og = xb_add(&bar[XB_TOP], 1u);
            const unsigned tg = og / nx;
            if (og + 1u == (tg + 1u) * nx) xb_add(&bar[XB_TOPGEN], 1u);
            else XB_SPIN(xb_ld(&bar[XB_TOPGEN]) == tg, bar);
            __builtin_amdgcn_fence(__ATOMIC_ACQUIRE, "agent");
            xb_add(&bar[XB_XGEN(b.x)], 1u);
            asm volatile("s_waitcnt vmcnt(0)" ::: "memory");
        } else {
            XB_SPIN(xb_ld(&bar[XB_XGEN(b.x)]) == gen, bar);
            __builtin_amdgcn_fence(__ATOMIC_ACQUIRE, "agent");
            asm volatile("s_waitcnt vmcnt(0)" ::: "memory");
        }
    }
    __syncthreads();
}

struct Args { const float* in[16]; float* out; unsigned char* ws; int ph_lo, ph_hi; };
__global__ void __launch_bounds__(NTHREADS, 2) fwd_kernel(Args args) {
    __shared__ __attribute__((aligned(16))) unsigned char lds_raw[LDS_BYTES];
    LAS unsigned char* L = (LAS unsigned char*)lds_raw;
    const int tid = threadIdx.x, lane = tid & 63, wave = __builtin_amdgcn_readfirstlane(tid >> 6);
    const int G = gridDim.x, gw = blockIdx.x * 8 + wave, ngw = G * 8, gtid = blockIdx.x * NTHREADS + tid, ngt = G * NTHREADS;
    unsigned char* ws = args.ws; float* dout = args.out;
    const float* x = args.in[0]; const float* n_mix_pre = args.in[1]; const float* n_mix_post = args.in[2]; const float* n_mlp_pre = args.in[3]; const float* n_mlp_post = args.in[4];
    bf16_t* A = (bf16_t*)(ws + WS_A); bf16_t* Fb = (bf16_t*)(ws + WS_F);
    cg::grid_group grid = cg::this_grid();
    if (tid < 16) ((LAS unsigned*)(L + MISC_OFF))[tid] = 0u;
    __syncthreads();
    XcdBarrier xbar = xcd_barrier_post((unsigned*)(ws + WS_CTL), (volatile LAS unsigned*)(L + MISC_OFF));
#ifdef PROBE_XCC
    if (tid == 0) __hip_atomic_fetch_or((unsigned*)(ws + WS_CTL) + 12288 + (blockIdx.x & 7) * 64, 1u << xbar.x, __ATOMIC_RELAXED, __HIP_MEMORY_SCOPE_AGENT);
#endif
#ifdef PROBE_PH
    unsigned long long t_probe0 = 0, t_probe1 = 0;
#define PROBE_AT(k) do { if ((k) == PROBE_PH) t_probe0 = __builtin_amdgcn_s_memrealtime(); if ((k) == PROBE_PH + 1) t_probe1 = __builtin_amdgcn_s_memrealtime(); } while (0)
#else
#define PROBE_AT(k) do {} while (0)
#endif
    const int lo = args.ph_lo, hi = args.ph_hi;
#define IN(k) (lo <= (k) && (k) < hi)
#define SEAM(k) do { if (IN(k) && IN((k) + 1)) { if (args.ph_hi > NPH) grid.sync(); else xcd_barrier(xbar); } PROBE_AT((k) + 1); } while (0)
#define GEMM_PHASE(CFG, Aptr, Bptr, N_, K_) do { pg8::Gemm g{(const bf16_t*)(Aptr), (const bf16_t*)(Bptr), MTOK, (N_), (K_)}; pg8::StaticOrder S; S.init(MTOK, (N_), G, (int)blockIdx.x); \
        Epi<CFG> E{ws, dout}; pg8::gemm_phase<Epi<CFG>, pg8::StaticOrder, false, true>(L, g, S, E); } while (0)
    float* GA = (float*)(ws + WS_GA); float* SSp = (float*)(ws + WS_SS);
    PROBE_AT(0);
    if (IN(PH_PRO)) {
        convert_layer(L, gw, ngw, wave, lane, 1, args.in[5], DFF, DFF, DFF, args.in[8], args.in[14], args.in[15],
                      (bf16_t*)(ws + W0IN), (bf16_t*)(ws + W0OUT), (bf16_t*)(ws + W0UP), (bf16_t*)(ws + W0DN));
        { const float* lg = args.in[6]; float* lb = (float*)(ws + WS_LB);
          for (int i = gtid; i < DM; i += ngt) { const float a = lg[i], b = lg[DM + i], c = lg[2 * DM + i]; const float mx = fmaxf(a, fmaxf(b, c));
              const float ea = expf(a - mx), eb = expf(b - mx), ec = expf(c - mx); lb[i] = ea / (ea + eb + ec); } }
        row_pass(gw, ngw, lane, nullptr, x, nullptr, nullptr, n_mix_pre, A);
    }
    SEAM(PH_PRO);
    if (IN(PH_G1)) GEMM_PHASE(E_HGRN_IN, A, ws + W0IN, DFF, DM);
    SEAM(PH_G1);
    if (IN(PH_PREP0)) prep_phase<128, 128, 16, false>(L, tid, (bf16_t*)(ws + WS_Q), (const bf16_t*)(ws + WS_K0), dout, nullptr, nullptr, nullptr, (bf16_t*)(ws + WS_V), A, GA, Fb);
    SEAM(PH_PREP0);
    if (IN(PH_SCAN0)) {
        constexpr int SCAN0_ITEMS = NBATCH * 16 * (128 / 32);
        if ((int)blockIdx.x < SCAN0_ITEMS || G <= SCAN0_ITEMS) scan_phase<128, 128, 16, 3, 12, 2>(L, tid, (const bf16_t*)(ws + WS_Q), A, (const bf16_t*)(ws + WS_V), Fb, GA, SSp, (unsigned*)(ws + WS_CTL + 65536), (unsigned*)(ws + WS_CTL) + 4096 + 0 * 2048);
        if (G <= SCAN0_ITEMS) { __syncthreads(); convert_layer(L, gw, ngw, wave, lane, 14, args.in[5], DFF, DFF, DFF, args.in[8], args.in[14], args.in[15], (bf16_t*)(ws + W0IN), (bf16_t*)(ws + W0OUT), (bf16_t*)(ws + W0UP), (bf16_t*)(ws + W0DN));
            convert_layer(L, gw, ngw, wave, lane, 3, args.in[9], GLA_IN, GLA_IN, GLA_NPAD, args.in[13], nullptr, nullptr, (bf16_t*)(ws + W1IN), (bf16_t*)(ws + W1OUT), nullptr, nullptr); }
        else if ((int)blockIdx.x >= SCAN0_ITEMS) {
            convert_layer(L, ((int)blockIdx.x - SCAN0_ITEMS) * 8 + wave, (G - SCAN0_ITEMS) * 8, wave, lane, 14, args.in[5], DFF, DFF, DFF, args.in[8], args.in[14], args.in[15],
                          (bf16_t*)(ws + W0IN), (bf16_t*)(ws + W0OUT), (bf16_t*)(ws + W0UP), (bf16_t*)(ws + W0DN));
            convert_layer(L, ((int)blockIdx.x - SCAN0_ITEMS) * 8 + wave, (G - SCAN0_ITEMS) * 8, wave, lane, 3, args.in[9], GLA_IN, GLA_IN, GLA_NPAD, args.in[13], nullptr, nullptr,
                          (bf16_t*)(ws + W1IN), (bf16_t*)(ws + W1OUT), nullptr, nullptr);
        }
    }
    SEAM(PH_SCAN0);
    if (IN(PH_HN0)) hn_phase<128, 16>(gtid, ngt, Fb, (const bf16_t*)(ws + WS_G), args.in[7], A);
    SEAM(PH_HN0);
    if (IN(PH_G2)) GEMM_PHASE(E_PLAIN, A, ws + W0OUT, DM, DM);
    SEAM(PH_G2);
    if (IN(PH_ROW0A)) row_pass(gw, ngw, lane, Fb, x, n_mix_post, dout, n_mlp_pre, A);
    SEAM(PH_ROW0A);
    if (IN(PH_G3)) GEMM_PHASE(E_RELU2, A, ws + W0UP, DFF, DM);
    SEAM(PH_G3);
    if (IN(PH_G4)) GEMM_PHASE(E_PLAIN, ws + WS_U, ws + W0DN, DM, DFF);
    SEAM(PH_G4);
    if (IN(PH_ROW0B)) {
        r_load_w(L, tid, args.in[9]);
        for (int rb = blockIdx.x; rb < MTOK / 64; rb += G) {
            row_pass(rb * 64 + wave * 8, 1, lane, Fb, dout, n_mlp_post, dout, n_mix_pre + DM, A, rb * 64 + wave * 8 + 8);
            asm volatile("s_waitcnt vmcnt(0)" ::: "memory"); __syncthreads();
            r_block(L, tid, rb, A, (float*)(ws + WS_R16));
        }
        __syncthreads();
        convert_layer(L, gw, ngw, wave, lane, 12, args.in[9], GLA_IN, GLA_IN, GLA_NPAD, args.in[13], args.in[14] + (size_t)DM * DFF, args.in[15] + (size_t)DM * DFF,
                      (bf16_t*)(ws + W1IN), (bf16_t*)(ws + W1OUT), (bf16_t*)(ws + W1UP), (bf16_t*)(ws + W1DN));
    }
    SEAM(PH_ROW0B);
    if (IN(PH_G5)) GEMM_PHASE(E_GLA_IN, A, ws + W1IN, GLA_NPAD, DM);
    SEAM(PH_G5);
    if (IN(PH_PREP1)) prep_phase<256, 512, 4, true>(L, tid, (bf16_t*)(ws + WS_Q), (const bf16_t*)(ws + WS_K1), nullptr, (const float*)(ws + WS_R16), args.in[10], args.in[11], (bf16_t*)(ws + WS_V), A, GA, Fb);
    SEAM(PH_PREP1);
    if (IN(PH_SCAN1)) scan_phase<256, 512, 4, 2, 8, 1>(L, tid, (const bf16_t*)(ws + WS_Q), A, (const bf16_t*)(ws + WS_V), Fb, GA, SSp, (unsigned*)(ws + WS_CTL + 65536), (unsigned*)(ws + WS_CTL) + 4096 + 1 * 2048);
    SEAM(PH_SCAN1);
    if (IN(PH_HN1)) hn_phase<512, 4>(gtid, ngt, Fb, (const bf16_t*)(ws + WS_G), args.in[12], A);
    SEAM(PH_HN1);
    if (IN(PH_G6)) GEMM_PHASE(E_PLAIN, A, ws + W1OUT, DM, DM);
    SEAM(PH_G6);
    if (IN(PH_ROW1A)) row_pass(gw, ngw, lane, Fb, dout, n_mix_post + DM, dout, n_mlp_pre + DM, A);
    SEAM(PH_ROW1A);
    if (IN(PH_G7)) GEMM_PHASE(E_RELU2, A, ws + W1UP, DFF, DM);
    SEAM(PH_G7);
    if (IN(PH_G8)) GEMM_PHASE(E_PLAIN, ws + WS_U, ws + W1DN, DM, DFF);
    SEAM(PH_G8);
    if (IN(PH_ROW1B)) row_pass(gw, ngw, lane, Fb, dout, n_mlp_post + DM, dout, nullptr, nullptr);
#undef IN
#undef SEAM
#undef GEMM_PHASE
#ifdef PROBE_XCC
    if (blockIdx.x == 0 && tid == 0) { int bad = 0; unsigned all = 0; for (int i = 0; i < 8; ++i) { const unsigned m = __hip_atomic_load((unsigned*)(ws + WS_CTL) + 12288 + i * 64, __ATOMIC_RELAXED, __HIP_MEMORY_SCOPE_AGENT); bad += (__builtin_popcount(m) != 1); all |= m; }
        dout[0] += 100.f * (float)bad + (float)__builtin_popcount(all); }
#endif
#ifdef PROBE_PH
    PROBE_AT(NPH);
    if (blockIdx.x == 0 && tid == 0) dout[0] += (float)(t_probe1 - t_probe0) * 0.001f;
#endif
#ifdef DIAG_PREFIX
    grid.sync();
    for (int i = gtid; i < MTOK * DM; i += ngt) {
        unsigned hsh = __float_as_uint(dout[i]); hsh = (hsh >> 16) ^ (hsh & 0xffffu);
        for (int k = 0; k < 8; ++k) { const size_t widx = (size_t)i + (size_t)k * 33554432u; if (widx * 2 < WS_END) hsh = hsh * 31u + ((const unsigned short*)ws)[widx]; }
        dout[i] = (float)(hsh & 0xffffu);
    }
#endif
}

extern "C" void kernel_launch(void* const* d_in, const int* in_sizes, int n_in, void* d_out, int out_size, void* d_ws, size_t ws_size, hipStream_t stream) {
    static int grid = 0;
    if (grid == 0) {
        if (n_in != 16 || out_size != MTOK * DM || ws_size < WS_END) { fprintf(stderr, "kernel_launch: unexpected shapes (n_in %d, out %d, ws %zu)\n", n_in, out_size, ws_size); grid = -1; return; }
        int dev = 0, cus = 0, per_cu = 0;
        (void)hipGetDevice(&dev); (void)hipDeviceGetAttribute(&cus, hipDeviceAttributeMultiprocessorCount, dev);
        if (hipOccupancyMaxActiveBlocksPerMultiprocessor(&per_cu, (const void*)fwd_kernel, NTHREADS, 0) != hipSuccess || per_cu < 1) { fprintf(stderr, "kernel_launch: occupancy query gave %d\n", per_cu); per_cu = 1; }
        (void)hipGetLastError();
        grid = cus;
    }
    if (grid < 0) return;
    Args a{};
    for (int i = 0; i < 16; ++i) a.in[i] = (const float*)d_in[i];
    a.out = (float*)d_out; a.ws = (unsigned char*)d_ws;
    void* kargs[] = {&a};
    if (hipMemsetAsync((char*)d_ws + WS_CTL, 0, CTL_BYTES, stream) != hipSuccess) { fprintf(stderr, "kernel_launch: hipMemsetAsync failed\n"); return; }
#if MK_N_LAUNCHES == 1
#ifdef DIAG_PREFIX
    a.ph_lo = 0; a.ph_hi = DIAG_PREFIX + 1;
#else
    a.ph_lo = 0; a.ph_hi = NPH;
#endif
    hipError_t e = hipLaunchCooperativeKernel((const void*)fwd_kernel, dim3(grid), dim3(NTHREADS), kargs, 0, stream);
    if (e != hipSuccess) fprintf(stderr, "kernel_launch: cooperative launch failed: %s (grid %d)\n", hipGetErrorString(e), grid);
#else
    for (int ph = 0; ph < NPH; ++ph) {
        a.ph_lo = ph; a.ph_hi = ph + 1;
        hipError_t e = hipLaunchCooperativeKernel((const void*)fwd_kernel, dim3(grid), dim3(NTHREADS), kargs, 0, stream);
        if (e != hipSuccess) { fprintf(stderr, "kernel_launch: launch of phase %d failed: %s (grid %d)\n", ph, hipGetErrorString(e), grid); break; }
    }
#endif
}
```

```cpp
#include <hip/hip_runtime.h>
#include <hip/hip_cooperative_groups.h>
#include <cstdio>
#include <cstdint>
namespace cg = cooperative_groups;
namespace pg8 {
#define PG8_LAS __attribute__((address_space(3)))
typedef unsigned short bf16_t;
typedef short bf16x8 __attribute__((ext_vector_type(8)));
typedef float f32x4 __attribute__((ext_vector_type(4)));
typedef unsigned u32x4 __attribute__((ext_vector_type(4)));
constexpr int BM = 256, BK = 64, HALF = 128, HTB = HALF * BK * 2  , STAGE_BYTES = 8 * HTB, NXCD = 8, WGM = 8;

__host__ __device__ __forceinline__ int lds_byte(int r, int c) { const int st = (r >> 4) * 2 + (c >> 5), rr = r & 15, cc = c & 31, ob = rr * 64 + cc * 2; return st * 1024 + (ob ^ (((ob >> 9) & 1) << 5)); }
__host__ __device__ __forceinline__ void stage_rc(int b, int& R, int& C) { const int st = b / 1024, sb = b % 1024, swz = sb ^ (((sb >> 9) & 1) << 5); R = (st >> 1) * 16 + swz / 64; C = (st & 1) * 32 + (swz % 64) / 2; }
__host__ __device__ __forceinline__ int perm32(int rho) { const int n = rho >> 4, i = rho & 15; return 8 * (i >> 2) + 4 * n + (i & 3); }

struct Unit { int pm, pn; };
struct Gemm { const bf16_t* A; const bf16_t* Bt; int M, N, K; };

struct StaticOrder {
    int nM, nN, nwg, G, c;
    __host__ __device__ void init(int M, int N, int G_, int c_) { nM = M / BM; nN = N / BM; nwg = nM * nN; G = G_; c = c_; }
    __host__ __device__ bool next(int i, Unit& u) const {
        const long L = (long)i * G + c; if (L >= nwg) return false;
        int wgid = (int)L; { const int q = nwg / NXCD, r = nwg % NXCD, xcd = wgid % NXCD, off = wgid / NXCD; wgid = (xcd < r ? xcd * (q + 1) : r * (q + 1) + (xcd - r) * q) + off; }
        const int nig = WGM * nN, gid = wgid / nig, fm = gid * WGM, gsz = (nM - fm) < WGM ? (nM - fm) : WGM;
        u.pm = fm + ((wgid % nig) % gsz); u.pn = (wgid % nig) / gsz; return true;
    }
    __device__ __forceinline__ void a_ready(const Unit&) const {}
    __device__ __forceinline__ void done(const Unit&) const {}
};

typedef float f32x2_t __attribute__((ext_vector_type(2)));
typedef __bf16 bf16x2_t __attribute__((ext_vector_type(2)));
__device__ __forceinline__ unsigned cvt_pk_bf16(float lo, float hi) { f32x2_t v = {lo, hi}; bf16x2_t b = __builtin_convertvector(v, bf16x2_t); return __builtin_bit_cast(unsigned, b); }
template <class Epi, class Sched, bool ALIGN_EPI = false, bool SP2 = false>
__device__ __forceinline__ void gemm_phase(PG8_LAS unsigned char* lds, const Gemm g, const Sched& S, const Epi& E) {
    const int tid = threadIdx.x, wid = __builtin_amdgcn_readfirstlane(tid >> 6), lane = tid & 63, wr = wid >> 2, wc = wid & 3, fr = lane & 15, fq = lane >> 4;
    const int K = g.K, nt = K / BK;
    unsigned voffA[2], voffB[2];
#pragma unroll
    for (int i = 0; i < 2; ++i) { int R, C; stage_rc(tid * 16 + i * 8192, R, C); const int Rb = Epi::PERM ? ((R & ~31) + perm32(R & 31)) : R;
        voffA[i] = (unsigned)(R * K + C) * 2u; voffB[i] = (unsigned)(Rb * K + C) * 2u; }
    const size_t kstep = (size_t)(BK * 2);
    const size_t hstep = (size_t)HALF * K * 2;
    const size_t tstep = 2 * hstep;
    const unsigned ldsw = (unsigned)wid * 1024u;
    const int aoff = lds_byte(wr * 64 + fr, fq * 8), boff = lds_byte(wc * 32 + fr, fq * 8);
#define PG8_SA(b, h) (((b) * 2 + (h)) * HTB)
#define PG8_SB(b, h) ((4 + (b) * 2 + (h)) * HTB)
#define PG8_STAGE(bufoff, gbase, voff) do { _Pragma("unroll") for (int _i = 0; _i < 2; ++_i) \
        __builtin_amdgcn_global_load_lds((const unsigned*)((const char*)(gbase) + (voff)[_i]), (PG8_LAS unsigned*)(lds + (bufoff) + ldsw + _i * 8192), 16, 0, 0); } while (0)
#define PG8_LDA(dst, b, h) do { _Pragma("unroll") for (int m = 0; m < 4; ++m) _Pragma("unroll") for (int k = 0; k < 2; ++k) dst[m][k] = *(const PG8_LAS bf16x8*)(lds + PG8_SA(b, h) + aoff + m * 2048 + k * 1024); } while (0)
#define PG8_LDB(dst, b, h) do { _Pragma("unroll") for (int n = 0; n < 2; ++n) _Pragma("unroll") for (int k = 0; k < 2; ++k) dst[n][k] = *(const PG8_LAS bf16x8*)(lds + PG8_SB(b, h) + boff + n * 2048 + k * 1024); } while (0)
#define PG8_MMA(ai, bj, At, Bt) do { __builtin_amdgcn_s_setprio(1); _Pragma("unroll") for (int m = 0; m < 4; ++m) _Pragma("unroll") for (int n = 0; n < 2; ++n) _Pragma("unroll") for (int k = 0; k < 2; ++k) \
        acc[ai][bj][m][n] = __builtin_amdgcn_mfma_f32_16x16x32_bf16(Bt[n][k], At[m][k], acc[ai][bj][m][n], 0, 0, 0); __builtin_amdgcn_s_setprio(0); } while (0)
#define PG8_WAIT_V(n) asm volatile("s_waitcnt vmcnt(" #n ")" ::: "memory")
#define PG8_WAIT_L(n) asm volatile("s_waitcnt lgkmcnt(" #n ")" ::: "memory")
#define PG8_BAR __builtin_amdgcn_s_barrier()
#define PG8_SCHED __builtin_amdgcn_sched_barrier(0)
    Unit cur, nxt; int ui = 0;
    if (!S.next(0, cur)) return;
    f32x4 acc[2][2][4][2];
#pragma unroll
    for (int a = 0; a < 2; ++a)
#pragma unroll
        for (int b = 0; b < 2; ++b)
#pragma unroll
            for (int m = 0; m < 4; ++m)
#pragma unroll
                for (int n = 0; n < 2; ++n) acc[a][b][m][n] = (f32x4){0.f, 0.f, 0.f, 0.f};
    bf16x8 At[4][2], B0[2][2], B1[2][2];
    const char* cA = (const char*)g.A + (size_t)cur.pm * tstep; const char* cB = (const char*)g.Bt + (size_t)cur.pn * tstep;
    S.a_ready(cur);
    if constexpr (SP2) {
        PG8_STAGE(PG8_SB(0, 0), cB, voffB); PG8_STAGE(PG8_SB(0, 1), cB + hstep, voffB); PG8_STAGE(PG8_SA(0, 0), cA, voffA); PG8_STAGE(PG8_SA(0, 1), cA + hstep, voffA);
        if (wr == 1) PG8_BAR;
        PG8_WAIT_V(2); PG8_BAR;
        PG8_STAGE(PG8_SB(1, 0), cB + kstep, voffB); PG8_STAGE(PG8_SA(1, 0), cA + kstep, voffA); PG8_STAGE(PG8_SB(1, 1), cB + hstep + kstep, voffB);
        PG8_WAIT_V(6); PG8_BAR;
    } else {
        PG8_STAGE(PG8_SB(0, 0), cB, voffB); PG8_STAGE(PG8_SA(0, 0), cA, voffA); PG8_STAGE(PG8_SB(0, 1), cB + hstep, voffB); PG8_STAGE(PG8_SA(0, 1), cA + hstep, voffA);
        if (wr == 1) PG8_BAR;
        PG8_WAIT_V(4); PG8_BAR;
        PG8_STAGE(PG8_SB(1, 0), cB + kstep, voffB); PG8_STAGE(PG8_SA(1, 0), cA + kstep, voffA); PG8_STAGE(PG8_SB(1, 1), cB + hstep + kstep, voffB);
        PG8_WAIT_V(6); PG8_BAR;
    }
    for (;;) {
        const bool has_next = S.next(ui + 1, nxt);
        const char* nA = has_next ? (const char*)g.A + (size_t)nxt.pm * tstep : cA; const char* nB = has_next ? (const char*)g.Bt + (size_t)nxt.pn * tstep : cB;
        for (int t = 0; t < nt; t += 2) {
            const bool last = (t == nt - 2);
            const char* a1 = cA + (size_t)(t + 1) * kstep;
            const char* a2 = last ? nA : cA + (size_t)(t + 2) * kstep; const char* b2 = last ? nB : cB + (size_t)(t + 2) * kstep;
            const char* a3 = a2 + kstep; const char* b3 = b2 + kstep;
            if (last && has_next) S.a_ready(nxt);
            if constexpr (SP2) {
            PG8_LDB(B0, 0, 0); PG8_LDB(B1, 0, 1); PG8_SCHED; PG8_LDA(At, 0, 0); PG8_STAGE(PG8_SA(1, 1), a1 + hstep, voffA);
            PG8_WAIT_V(8); PG8_WAIT_L(0); PG8_BAR; PG8_MMA(0, 0, At, B0); PG8_MMA(0, 1, At, B1); PG8_BAR; PG8_SCHED;
            PG8_LDA(At, 0, 1); PG8_STAGE(PG8_SB(0, 0), b2, voffB); PG8_STAGE(PG8_SB(0, 1), b2 + hstep, voffB); PG8_STAGE(PG8_SA(0, 0), a2, voffA);
            PG8_WAIT_V(8); PG8_WAIT_L(0); PG8_BAR; PG8_MMA(1, 0, At, B0); PG8_MMA(1, 1, At, B1); PG8_BAR; PG8_SCHED;
            PG8_LDB(B0, 1, 0); PG8_LDB(B1, 1, 1); PG8_SCHED; PG8_LDA(At, 1, 0); PG8_STAGE(PG8_SA(0, 1), a2 + hstep, voffA);
            PG8_WAIT_V(8); PG8_WAIT_L(0); PG8_BAR; PG8_MMA(0, 0, At, B0); PG8_MMA(0, 1, At, B1); PG8_BAR; PG8_SCHED;
            PG8_LDA(At, 1, 1); PG8_STAGE(PG8_SB(1, 0), b3, voffB); PG8_STAGE(PG8_SB(1, 1), b3 + hstep, voffB); PG8_STAGE(PG8_SA(1, 0), a3, voffA);
            PG8_WAIT_V(8); PG8_WAIT_L(0); PG8_BAR; PG8_MMA(1, 0, At, B0); PG8_MMA(1, 1, At, B1); PG8_BAR; PG8_SCHED;
            } else {
            PG8_LDB(B0, 0, 0); PG8_SCHED; PG8_LDA(At, 0, 0); PG8_STAGE(PG8_SA(1, 1), a1 + hstep, voffA);
            PG8_WAIT_L(8); PG8_BAR; PG8_WAIT_L(0); PG8_MMA(0, 0, At, B0); PG8_BAR; PG8_SCHED;
            PG8_LDB(B1, 0, 1); PG8_STAGE(PG8_SB(0, 0), b2, voffB);
            PG8_BAR; PG8_WAIT_L(0); PG8_MMA(0, 1, At, B1); PG8_BAR;
            PG8_LDA(At, 0, 1); PG8_STAGE(PG8_SA(0, 0), a2, voffA);
            PG8_BAR; PG8_WAIT_L(0); PG8_MMA(1, 0, At, B0); PG8_BAR; PG8_SCHED;
            PG8_STAGE(PG8_SB(0, 1), b2 + hstep, voffB);
            PG8_WAIT_V(6); PG8_BAR; PG8_MMA(1, 1, At, B1); PG8_BAR;
            PG8_LDB(B0, 1, 0); PG8_SCHED; PG8_LDA(At, 1, 0); PG8_STAGE(PG8_SA(0, 1), a2 + hstep, voffA);
            PG8_WAIT_L(8); PG8_BAR; PG8_WAIT_L(0); PG8_MMA(0, 0, At, B0); PG8_BAR; PG8_SCHED;
            PG8_LDB(B1, 1, 1); PG8_STAGE(PG8_SB(1, 0), b3, voffB);
            PG8_BAR; PG8_WAIT_L(0); PG8_MMA(0, 1, At, B1); PG8_BAR;
            PG8_LDA(At, 1, 1); PG8_STAGE(PG8_SA(1, 0), a3, voffA);
            PG8_BAR; PG8_WAIT_L(0); PG8_MMA(1, 0, At, B0); PG8_BAR; PG8_SCHED;
            PG8_STAGE(PG8_SB(1, 1), b3 + hstep, voffB);
            PG8_WAIT_V(6); PG8_BAR; PG8_MMA(1, 1, At, B1); PG8_BAR;
            }
        }
        if constexpr (ALIGN_EPI) { if (wr == 0) PG8_BAR; }
        if constexpr (!Epi::AFTER_DRAIN) { E(acc, cur, wr, wc, fr, fq); S.done(cur); }
        if (!has_next) break;
#pragma unroll
        for (int a = 0; a < 2; ++a)
#pragma unroll
            for (int b = 0; b < 2; ++b)
#pragma unroll
                for (int m = 0; m < 4; ++m)
#pragma unroll
                    for (int n = 0; n < 2; ++n) acc[a][b][m][n] = (f32x4){0.f, 0.f, 0.f, 0.f};
        cur = nxt; cA = nA; cB = nB; ++ui;
        if constexpr (ALIGN_EPI) { if (wr == 1) PG8_BAR; }
    }
    PG8_WAIT_V(0);
    if constexpr (!ALIGN_EPI) { if (wr == 0) PG8_BAR; }
    PG8_BAR;
    if constexpr (Epi::AFTER_DRAIN) { E.fused(acc, cur, wr, wc, fr, fq, lds, wid, lane); S.done(cur); }
#undef PG8_SA
#undef PG8_SB
#undef PG8_STAGE
#undef PG8_LDA
#undef PG8_LDB
#undef PG8_MMA
#undef PG8_WAIT_V
#undef PG8_WAIT_L
#undef PG8_BAR
#undef PG8_SCHED
}
}

#ifndef MK_N_LAUNCHES
#define MK_N_LAUNCHES 1
#endif
#define LAS __attribute__((address_space(3)))
typedef unsigned short bf16_t;
typedef short bf16x8 __attribute__((ext_vector_type(8)));
typedef float f32x4 __attribute__((ext_vector_type(4)));
typedef unsigned u32x4 __attribute__((ext_vector_type(4)));
typedef unsigned u32x2 __attribute__((ext_vector_type(2)));
using pg8::cvt_pk_bf16;

constexpr int MTOK = 16384, DM = 2048, DFF = 8192, SEQ = 8192, NBATCH = 2, CHUNK = 64, NCHUNK = MTOK / CHUNK, CPB = SEQ / CHUNK;
constexpr float NEPS = 1e-6f;
constexpr int GLA_IN = 6160, GLA_NPAD = 6144;
constexpr size_t MiB = 1u << 20;
constexpr size_t WS_W = 0;
constexpr size_t W0IN = 0, W0OUT = 32 * MiB, W0UP = 40 * MiB, W0DN = 72 * MiB;
constexpr size_t W1IN = 0, W1OUT = 505 * MiB, W1UP = 40 * MiB, W1DN = 72 * MiB;
constexpr size_t WS_Q = 104 * MiB, WS_K0 = 168 * MiB, WS_K1 = 136 * MiB, WS_V = 232 * MiB, WS_G = 296 * MiB, WS_U = 104 * MiB;
constexpr size_t WS_A = 360 * MiB;
constexpr size_t WS_F = 424 * MiB;
constexpr size_t WS_AL = 488 * MiB, WS_BE = 490 * MiB, WS_GA = 492 * MiB;
constexpr size_t WS_SS = 494 * MiB;
constexpr size_t WS_R16 = 502 * MiB;
constexpr size_t WS_LB = 503 * MiB;
constexpr size_t WS_CTL = 504 * MiB, CTL_BYTES = 65536;
constexpr size_t WS_END = 513 * MiB;
constexpr int MISC_OFF = 147456 - 64;
constexpr int LDS_BYTES = 147456;
constexpr int NTHREADS = 512;

enum { PH_PRO = 0, PH_G1, PH_PREP0, PH_SCAN0, PH_HN0, PH_G2, PH_ROW0A, PH_G3, PH_G4, PH_ROW0B, PH_G5, PH_PREP1, PH_SCAN1, PH_HN1, PH_G6, PH_ROW1A, PH_G7, PH_G8, PH_ROW1B, NPH };
enum { E_PLAIN = 0, E_RELU2, E_HGRN_IN, E_GLA_IN };
enum { M_NONE = 0, M_SILU, M_RELU2, M_FGATE, M_R16 };

#define LDS_WAIT() asm volatile("s_waitcnt lgkmcnt(0)" ::: "memory")
#define LDS_BAR() do { asm volatile("s_waitcnt lgkmcnt(0)" ::: "memory"); __builtin_amdgcn_s_barrier(); asm volatile("" ::: "memory"); } while (0)

__device__ __forceinline__ float bf2f(unsigned short b) { return __uint_as_float(((unsigned)b) << 16); }
__device__ __forceinline__ float bflo(unsigned w) { return __uint_as_float(w << 16); }
__device__ __forceinline__ float bfhi(unsigned w) { return __uint_as_float(w & 0xffff0000u); }
__device__ __forceinline__ float wave_sum(float v) {
#pragma unroll
    for (int o = 1; o < 64; o <<= 1) v += __shfl_xor(v, o);
    return v;
}

template <int cfg> struct Epi {
    static constexpr bool PERM = true, AFTER_DRAIN = false;
    unsigned char* ws; float* dout;
    __device__ __forceinline__ void operator()(const f32x4 (&acc)[2][2][4][2], const pg8::Unit& u, int wr, int wc, int fr, int fq) const {
        const int row0 = u.pm * 256 + wr * 64 + fr;
        const int cin = wc * 32 + 8 * fq;
        int mode = M_NONE, ldo = DM, colt = u.pn * 256; float sc = 1.f; bf16_t* O = (bf16_t*)(ws + WS_F);
        if (cfg == E_RELU2) { mode = M_RELU2; O = (bf16_t*)(ws + WS_U); ldo = DFF; }
        else if (cfg == E_HGRN_IN) {
            const int seg = u.pn >> 3; colt = (u.pn & 7) * 256;
            if (seg == 0) { mode = M_SILU; O = (bf16_t*)(ws + WS_Q); }
            else if (seg == 1) { mode = M_FGATE; O = (bf16_t*)(ws + WS_K0); }
            else if (seg == 2) { O = (bf16_t*)(ws + WS_V); }
            else { O = (bf16_t*)(ws + WS_G); }
        } else if (cfg == E_GLA_IN) {
            if (u.pn < 4) { O = (bf16_t*)(ws + WS_Q); ldo = 1024; sc = 0.0625f; }
            else if (u.pn < 8) { O = (bf16_t*)(ws + WS_K1); ldo = 1024; colt = (u.pn - 4) * 256; }
            else if (u.pn < 16) { O = (bf16_t*)(ws + WS_V); colt = (u.pn - 8) * 256; }
            else if (u.pn < 24) { O = (bf16_t*)(ws + WS_G); colt = (u.pn - 16) * 256; }
            else { mode = M_R16; }
        }
        if (mode == M_FGATE) {
            const float* lb = (const float*)(ws + WS_LB);
#pragma unroll
            for (int bj = 0; bj < 2; ++bj) {
                const int col = colt + bj * 128 + cin;
                const f32x4 l0 = *(const f32x4*)(lb + col), l1 = *(const f32x4*)(lb + col + 4);
#pragma unroll
                for (int ai = 0; ai < 2; ++ai)
#pragma unroll
                    for (int m = 0; m < 4; ++m) {
                        const size_t row = (size_t)(row0 + ai * 128 + m * 16);
                        f32x4 k0, k1, f0, f1;
#pragma unroll
                        for (int j = 0; j < 4; ++j) {
                            const float a = acc[ai][bj][m][0][j], b = acc[ai][bj][m][1][j];
                            k0[j] = (1.f - l0[j]) * __builtin_amdgcn_rcpf(1.f + __expf(a)); k1[j] = (1.f - l1[j]) * __builtin_amdgcn_rcpf(1.f + __expf(b));
                            f0[j] = __logf(1.f - k0[j]); f1[j] = __logf(1.f - k1[j]);
                        }
                        u32x4 w; w.x = cvt_pk_bf16(k0[0], k0[1]); w.y = cvt_pk_bf16(k0[2], k0[3]); w.z = cvt_pk_bf16(k1[0], k1[1]); w.w = cvt_pk_bf16(k1[2], k1[3]);
                        *(u32x4*)(O + row * DM + col) = w;
                        { typedef _Float16 h16x2 __attribute__((ext_vector_type(2))); typedef float f32x2e __attribute__((ext_vector_type(2)));
                          u32x4 lw;
                          lw.x = __builtin_bit_cast(unsigned, __builtin_convertvector((f32x2e){f0[0], f0[1]}, h16x2)); lw.y = __builtin_bit_cast(unsigned, __builtin_convertvector((f32x2e){f0[2], f0[3]}, h16x2));
                          lw.z = __builtin_bit_cast(unsigned, __builtin_convertvector((f32x2e){f1[0], f1[1]}, h16x2)); lw.w = __builtin_bit_cast(unsigned, __builtin_convertvector((f32x2e){f1[2], f1[3]}, h16x2));
                          *(u32x4*)((_Float16*)dout + row * DM + col) = lw; }
                    }
            }
        } else if (mode == M_R16) {
            if (wc == 0 && fq < 2) {
                float* R = (float*)(ws + WS_R16);
#pragma unroll
                for (int ai = 0; ai < 2; ++ai)
#pragma unroll
                    for (int m = 0; m < 4; ++m) {
                        const size_t row = (size_t)(row0 + ai * 128 + m * 16);
                        *(f32x4*)(R + row * 16 + 8 * fq) = acc[ai][0][m][0]; *(f32x4*)(R + row * 16 + 8 * fq + 4) = acc[ai][0][m][1];
                    }
            }
        } else {
#pragma unroll
            for (int ai = 0; ai < 2; ++ai)
#pragma unroll
                for (int m = 0; m < 4; ++m) {
                    bf16_t* rowp = O + (size_t)(row0 + ai * 128 + m * 16) * ldo + colt + cin;
#pragma unroll
                    for (int bj = 0; bj < 2; ++bj) {
                        f32x4 v0 = acc[ai][bj][m][0], v1 = acc[ai][bj][m][1];
                        if (mode == M_SILU) {
#pragma unroll
                            for (int j = 0; j < 4; ++j) { v0[j] = v0[j] / (1.f + __expf(-v0[j])); v1[j] = v1[j] / (1.f + __expf(-v1[j])); }
                        } else if (mode == M_RELU2) {
#pragma unroll
                            for (int j = 0; j < 4; ++j) { const float a = fmaxf(v0[j], 0.f), b = fmaxf(v1[j], 0.f); v0[j] = a * a; v1[j] = b * b; }
                        } else { v0 = v0 * sc; v1 = v1 * sc; }
                        u32x4 w; w.x = cvt_pk_bf16(v0[0], v0[1]); w.y = cvt_pk_bf16(v0[2], v0[3]); w.z = cvt_pk_bf16(v1[0], v1[1]); w.w = cvt_pk_bf16(v1[2], v1[3]);
                        *(u32x4*)(rowp + bj * 128) = w;
                    }
                }
        }
    }
};

__device__ __forceinline__ void transpose_item(const float* W, int ldw, int nvalid, bf16_t* WT, int K, LAS float* scr, int kb, int nb, int lane) {
    const int k0 = 64 * kb, n0 = 64 * nb;
    const int kk = lane >> 4, n4 = (lane & 15) * 4;
    const bool ok = (n0 + n4) < nvalid;
    f32x4 v[16];
#pragma unroll
    for (int i = 0; i < 16; ++i) v[i] = ok ? *(const f32x4*)(W + (size_t)(k0 + 4 * i + kk) * ldw + n0 + n4) : (f32x4){0.f, 0.f, 0.f, 0.f};
#pragma unroll
    for (int i = 0; i < 16; ++i) { LAS float* d = scr + (4 * i + kk) * 65 + n4; d[0] = v[i][0]; d[1] = v[i][1]; d[2] = v[i][2]; d[3] = v[i][3]; }
    LDS_WAIT();
    const int c = lane & 7;
#pragma unroll
    for (int j = 0; j < 8; ++j) { const int nn = (lane >> 3) + 8 * j; const LAS float* s = scr + (8 * c) * 65 + nn;
        u32x4 o; o.x = cvt_pk_bf16(s[0 * 65], s[1 * 65]); o.y = cvt_pk_bf16(s[2 * 65], s[3 * 65]); o.z = cvt_pk_bf16(s[4 * 65], s[5 * 65]); o.w = cvt_pk_bf16(s[6 * 65], s[7 * 65]);
        *(u32x4*)(WT + (size_t)(n0 + nn) * K + k0 + 8 * c) = o; }
    LDS_WAIT();
}
__device__ __forceinline__ void convert_layer(LAS unsigned char* L, int gw, int ngw, int wave, int lane, int mask, const float* w_in, int ld_in, int nvalid_in, int nrows_in, const float* w_out, const float* w_up, const float* w_dn,
                                              bf16_t* t_in, bf16_t* t_out, bf16_t* t_up, bf16_t* t_dn) {
    LAS float* scr = (LAS float*)(L + wave * 16640);
    const int nb_in = nrows_in / 64;
    const int I_IN = (DM / 64) * nb_in, I_OUT = (DM / 64) * (DM / 64), I_UP = (DM / 64) * (DFF / 64), I_DN = (DFF / 64) * (DM / 64);
    const int lo_it = (mask & 1) ? 0 : (mask & 2) ? I_IN : (mask & 4) ? I_IN + I_OUT : I_IN + I_OUT + I_UP;
    const int hi_it = (mask & 8) ? I_IN + I_OUT + I_UP + I_DN : (mask & 4) ? I_IN + I_OUT + I_UP : (mask & 2) ? I_IN + I_OUT : I_IN;
    for (int it = lo_it + gw; it < hi_it; it += ngw) {
        int r = it;
        if (r < I_IN) { transpose_item(w_in, ld_in, nvalid_in, t_in, DM, scr, r / nb_in, r % nb_in, lane); continue; } r -= I_IN;
        if (r < I_OUT) { transpose_item(w_out, DM, DM, t_out, DM, scr, r / (DM / 64), r % (DM / 64), lane); continue; } r -= I_OUT;
        if (r < I_UP) { transpose_item(w_up, DFF, DFF, t_up, DM, scr, r / (DFF / 64), r % (DFF / 64), lane); continue; } r -= I_UP;
        transpose_item(w_dn, DM, DM, t_dn, DFF, scr, r / (DM / 64), r % (DM / 64), lane);
    }
}

__device__ __forceinline__ void row_pass(int gw, int ngw, int lane, const bf16_t* msrc, const float* hin, const float* wpost, float* hout, const float* wpre, bf16_t* hn, int row_end = MTOK) {
    for (int row = gw; row < row_end; row += ngw) {
        f32x4 h[4][2];
#pragma unroll
        for (int j = 0; j < 4; ++j) { const float* p = hin + (size_t)row * DM + j * 512 + lane * 8; h[j][0] = *(const f32x4*)p; h[j][1] = *(const f32x4*)(p + 4); }
        if (msrc) {
            f32x4 mv[4][2]; float ss = 0.f;
#pragma unroll
            for (int j = 0; j < 4; ++j) { const u32x4 w = *(const u32x4*)(msrc + (size_t)row * DM + j * 512 + lane * 8);
                mv[j][0] = (f32x4){bflo(w.x), bfhi(w.x), bflo(w.y), bfhi(w.y)}; mv[j][1] = (f32x4){bflo(w.z), bfhi(w.z), bflo(w.w), bfhi(w.w)};
#pragma unroll
                for (int q = 0; q < 4; ++q) ss += mv[j][0][q] * mv[j][0][q] + mv[j][1][q] * mv[j][1][q]; }
            const float rstd = rsqrtf(wave_sum(ss) * (1.f / DM) + NEPS);
#pragma unroll
            for (int j = 0; j < 4; ++j) { const float* wp = wpost + j * 512 + lane * 8; const f32x4 w0 = *(const f32x4*)wp, w1 = *(const f32x4*)(wp + 4);
                h[j][0] = h[j][0] + mv[j][0] * rstd * w0; h[j][1] = h[j][1] + mv[j][1] * rstd * w1;
                float* op = hout + (size_t)row * DM + j * 512 + lane * 8; *(f32x4*)op = h[j][0]; *(f32x4*)(op + 4) = h[j][1]; }
        }
        if (wpre) {
            float ss = 0.f;
#pragma unroll
            for (int j = 0; j < 4; ++j)
#pragma unroll
                for (int q = 0; q < 4; ++q) ss += h[j][0][q] * h[j][0][q] + h[j][1][q] * h[j][1][q];
            const float rstd = rsqrtf(wave_sum(ss) * (1.f / DM) + NEPS);
#pragma unroll
            for (int j = 0; j < 4; ++j) { const float* wp = wpre + j * 512 + lane * 8; const f32x4 w0 = *(const f32x4*)wp, w1 = *(const f32x4*)(wp + 4);
                const f32x4 a = h[j][0] * rstd * w0, b = h[j][1] * rstd * w1;
                u32x4 o; o.x = cvt_pk_bf16(a[0], a[1]); o.y = cvt_pk_bf16(a[2], a[3]); o.z = cvt_pk_bf16(b[0], b[1]); o.w = cvt_pk_bf16(b[2], b[3]);
                *(u32x4*)(hn + (size_t)row * DM + j * 512 + lane * 8) = o; }
        }
    }
}

template <int DK, int DV, int H, bool GLA>
__device__ __forceinline__ void prep_phase(LAS unsigned char* L, int tid, bf16_t* Q, const bf16_t* Kin, const float* LF, const float* R16, const float* wgk, const float* bgk,
                                           bf16_t* V, bf16_t* Ktt, float* GA, bf16_t* OI) {
    constexpr int DKT = DK * H, DVT = DV * H, NCP = DK / 2, NSEG = NTHREADS / NCP, SEGL = 64 / NSEG, QSTR = DK + 8, PSTR = 72, DVC = (DV > 256) ? 256 : DV, NDVC = DV / DVC, EPRC = DVC / 64;
    constexpr int VIT = (64 * DVC / 8) / NTHREADS;
    constexpr int OFF_QS = 0, OFF_KS = 64 * QSTR * 2, OFF_P = 2 * 64 * QSTR * 2, OFF_VT = OFF_P + 64 * PSTR * 2, OFF_SEG = OFF_VT + DVC * PSTR * 2;
    static_assert(OFF_SEG + NSEG * DK * 4 <= 131072, "prep LDS");
    LAS bf16_t* Qs = (LAS bf16_t*)(L + OFF_QS); LAS bf16_t* Ks = (LAS bf16_t*)(L + OFF_KS); LAS bf16_t* Ps = (LAS bf16_t*)(L + OFF_P); LAS bf16_t* Vt = (LAS bf16_t*)(L + OFF_VT);
    LAS float* segsum = (LAS float*)(L + OFF_SEG);
    const int lane = tid & 63, wid = __builtin_amdgcn_readfirstlane(tid >> 6), fr = lane & 15, fg = lane >> 4;
    const int cp = tid % NCP, seg = __builtin_amdgcn_readfirstlane(tid / NCP), col = 2 * cp;
    typedef float f32x2v __attribute__((ext_vector_type(2)));
#define PREP_LOAD(tile_, qw_, kw_, vreg_, g0_, g1_) do { const int h_ = (tile_) % H, tk0_ = ((tile_) / H) * CHUNK; \
        _Pragma("unroll") for (int i = 0; i < SEGL; ++i) { const size_t ru = (size_t)(tk0_ + seg * SEGL + i) * DKT + h_ * DK; \
            qw_[i] = *(const unsigned*)(Q + ru + col); kw_[i] = *(const unsigned*)(Kin + ru + col); \
            { typedef _Float16 h16x2_ __attribute__((ext_vector_type(2))); const h16x2_ v_ = *(const h16x2_*)((const _Float16*)LF + ru + col); g0_[i] = (float)v_.x; g1_[i] = (float)v_.y; } } \
        _Pragma("unroll") for (int itx = 0; itx < VIT; ++itx) { const int item = itx * NTHREADS + tid, tok = item & 63, e8 = item >> 6; \
            vreg_[itx] = *(const u32x4*)(V + (size_t)(tk0_ + tok) * DVT + h_ * DV + e8 * 8); } } while (0)
    unsigned qwn[SEGL], kwn[SEGL]; u32x4 vregn[VIT]; float g0n[SEGL], g1n[SEGL];
    if (!GLA) { if ((int)blockIdx.x < NCHUNK * H) PREP_LOAD((int)blockIdx.x, qwn, kwn, vregn, g0n, g1n); }
    for (int tile = blockIdx.x; tile < NCHUNK * H; tile += gridDim.x) {
        const int h = tile % H, cgi = tile / H, token0 = cgi * CHUNK, gcol = h * DK + col;
        unsigned qw[SEGL], kw[SEGL]; u32x4 vreg[VIT]; float g0[SEGL], g1[SEGL];
        if (GLA) {
#pragma unroll
            for (int itx = 0; itx < VIT; ++itx) { const int item = itx * NTHREADS + tid, tok = item & 63, e8 = item >> 6;
                vreg[itx] = *(const u32x4*)(V + (size_t)(token0 + tok) * DVT + h * DV + e8 * 8); }
            float wk0[16], wk1[16];
#pragma unroll
            for (int r = 0; r < 16; ++r) { const f32x2v w = *(const f32x2v*)(wgk + r * DKT + gcol); wk0[r] = w.x; wk1[r] = w.y; }
            const f32x2v bk = *(const f32x2v*)(bgk + gcol);
#pragma unroll
            for (int i = 0; i < SEGL; ++i) {
                const float* rp = R16 + (size_t)(token0 + seg * SEGL + i) * 16;
                float z0 = bk.x, z1 = bk.y;
#pragma unroll
                for (int r = 0; r < 16; ++r) { const float rv = rp[r]; z0 += rv * wk0[r]; z1 += rv * wk1[r]; }
                g0[i] = (fminf(z0, 0.f) - __logf(1.f + __expf(-fabsf(z0)))) * 0.0625f; g1[i] = (fminf(z1, 0.f) - __logf(1.f + __expf(-fabsf(z1)))) * 0.0625f;
                if ((i & 3) == 3) asm volatile("" ::: "memory");
            }
        } else {
#pragma unroll
            for (int i = 0; i < SEGL; ++i) { qw[i] = qwn[i]; kw[i] = kwn[i]; g0[i] = g0n[i]; g1[i] = g1n[i]; }
#pragma unroll
            for (int itx = 0; itx < VIT; ++itx) vreg[itx] = vregn[itx];
            if (tile + (int)gridDim.x < NCHUNK * H) PREP_LOAD(tile + (int)gridDim.x, qwn, kwn, vregn, g0n, g1n);
        }
#pragma unroll
        for (int i = 1; i < SEGL; ++i) { g0[i] += g0[i - 1]; g1[i] += g1[i - 1]; }
        *(LAS f32x2v*)(segsum + seg * DK + col) = (f32x2v){g0[SEGL - 1], g1[SEGL - 1]};
        LDS_BAR();
        float pre0 = 0.f, pre1 = 0.f, bref0 = 0.f, bref1 = 0.f, bl0 = 0.f, bl1 = 0.f;
#pragma unroll
        for (int s = 0; s < NSEG; ++s) { const f32x2v v = *(const LAS f32x2v*)(segsum + s * DK + col); if (s < seg) { pre0 += v.x; pre1 += v.y; } if (s < NSEG / 2) { bref0 += v.x; bref1 += v.y; } bl0 += v.x; bl1 += v.y; }
        if (seg == 0) *(f32x2v*)(GA + (size_t)cgi * DKT + gcol) = (f32x2v){__expf(bl0), __expf(bl1)};
        const float ea0 = __expf(bref0), ea1 = __expf(bref1), eb0 = __expf(bl0 - bref0), eb1 = __expf(bl1 - bref1);
        if (GLA) {
#pragma unroll
            for (int i = 0; i < SEGL; ++i) { const size_t ru = (size_t)(token0 + seg * SEGL + i) * DKT + h * DK; qw[i] = *(const unsigned*)(Q + ru + col); kw[i] = *(const unsigned*)(Kin + ru + col); }
        }
        float kh0[SEGL], kh1[SEGL]; unsigned qh[SEGL];
#pragma unroll
        for (int i = 0; i < SEGL; ++i) {
            const int tok = seg * SEGL + i;
            const float d0 = g0[i] + pre0 - bref0, d1 = g1[i] + pre1 - bref1;
            const float qt0 = bflo(qw[i]) * __expf(d0), qt1 = bfhi(qw[i]) * __expf(d1), kt0 = bflo(kw[i]) * __expf(-d0), kt1 = bfhi(kw[i]) * __expf(-d1);
            *(LAS unsigned*)(Qs + tok * QSTR + col) = cvt_pk_bf16(qt0, qt1);
            *(LAS unsigned*)(Ks + tok * QSTR + col) = cvt_pk_bf16(kt0, kt1);
            qh[i] = cvt_pk_bf16(qt0 * ea0, qt1 * ea1);
            kh0[i] = kt0 * eb0; kh1[i] = kt1 * eb1;
        }
#pragma unroll
        for (int i = 0; i < SEGL; i += 8) {
            u32x4 w0, w1;
            w0.x = cvt_pk_bf16(kh0[i], kh0[i + 1]); w0.y = cvt_pk_bf16(kh0[i + 2], kh0[i + 3]); w0.z = cvt_pk_bf16(kh0[i + 4], kh0[i + 5]); w0.w = cvt_pk_bf16(kh0[i + 6], kh0[i + 7]);
            w1.x = cvt_pk_bf16(kh1[i], kh1[i + 1]); w1.y = cvt_pk_bf16(kh1[i + 2], kh1[i + 3]); w1.z = cvt_pk_bf16(kh1[i + 4], kh1[i + 5]); w1.w = cvt_pk_bf16(kh1[i + 6], kh1[i + 7]);
            { const int tk = seg * SEGL + i; const size_t kb = (((size_t)cgi * (DKT / 16) + (gcol >> 4)) * 2 + (tk >> 5)) * 512 + (((tk & 31) >> 3) * 16) * 8;
              *(u32x4*)(Ktt + kb + (gcol & 15) * 8) = w0; *(u32x4*)(Ktt + kb + ((gcol + 1) & 15) * 8) = w1; }
        }
        LDS_BAR();
#pragma unroll
        for (int i = 0; i < SEGL; ++i) { const int tok = seg * SEGL + i; const int o = (((tok >> 4) * (DK / 32) + (col >> 5)) * 512) + ((((col & 31) >> 3) * 16 + (tok & 15)) * 8) + (col & 7);
            *(unsigned*)((bf16_t*)Q + ((size_t)(token0 + o / DK) * DKT + h * DK) + (o % DK)) = qh[i]; }
        {
            const int it = wid >> 1;
#pragma unroll
            for (int jj = 0; jj < 2; ++jj) {
                const int jt = 2 * (wid & 1) + jj;
                f32x4 acc = {0.f, 0.f, 0.f, 0.f};
                if (jt <= it) {
#pragma unroll
                    for (int ks = 0; ks < DK / 32; ++ks) {
                        const bf16x8 a = *(const LAS bf16x8*)(Ks + (jt * 16 + fr) * QSTR + ks * 32 + fg * 8);
                        const bf16x8 b = *(const LAS bf16x8*)(Qs + (it * 16 + fr) * QSTR + ks * 32 + fg * 8);
                        acc = __builtin_amdgcn_mfma_f32_16x16x32_bf16(a, b, acc, 0, 0, 0);
                    }
                    if (jt == it) {
#pragma unroll
                        for (int r = 0; r < 4; ++r) if (4 * fg + r > fr) acc[r] = 0.f;
                    }
                }
                u32x2 w; w.x = cvt_pk_bf16(acc[0], acc[1]); w.y = cvt_pk_bf16(acc[2], acc[3]);
                *(LAS u32x2*)(Ps + (it * 16 + fr) * PSTR + jt * 16 + 4 * fg) = w;
            }
        }
#pragma unroll
        for (int dc = 0; dc < NDVC; ++dc) {
            const int e0 = dc * DVC;
#pragma unroll
            for (int itx = 0; itx < VIT; ++itx) {
                const int item = itx * NTHREADS + tid, tok = item & 63, e8 = item >> 6;
                const u32x4 w = vreg[itx];
#pragma unroll
                for (int q = 0; q < 4; ++q) { Vt[(e8 * 8 + 2 * q) * PSTR + tok] = (unsigned short)(w[q] & 0xffffu); Vt[(e8 * 8 + 2 * q + 1) * PSTR + tok] = (unsigned short)(w[q] >> 16); }
                if (dc + 1 < NDVC) vreg[itx] = *(const u32x4*)(V + (size_t)(token0 + tok) * DVT + h * DV + (dc + 1) * DVC + e8 * 8);
            }
            LDS_BAR();
            const int it = wid & 3;
            const bf16x8 p0 = *(const LAS bf16x8*)(Ps + (it * 16 + fr) * PSTR + fg * 8), p1 = *(const LAS bf16x8*)(Ps + (it * 16 + fr) * PSTR + 32 + fg * 8);
#pragma unroll
            for (int k = 0; k < DVC / 32; ++k) {
                const int et = (wid >> 2) + 2 * k;
                const bf16x8 a0 = *(const LAS bf16x8*)(Vt + (et * 16 + fr) * PSTR + fg * 8), a1 = *(const LAS bf16x8*)(Vt + (et * 16 + fr) * PSTR + 32 + fg * 8);
                f32x4 acc = {0.f, 0.f, 0.f, 0.f};
                acc = __builtin_amdgcn_mfma_f32_16x16x32_bf16(a0, p0, acc, 0, 0, 0);
                acc = __builtin_amdgcn_mfma_f32_16x16x32_bf16(a1, p1, acc, 0, 0, 0);
                u32x2 w; w.x = cvt_pk_bf16(acc[0], acc[1]); w.y = cvt_pk_bf16(acc[2], acc[3]);
                *(u32x2*)(OI + ((((size_t)cgi * H + h) * (DV / 16) + (e0 >> 4) + et) * 64 + it * 16 + fr) * 16 + 4 * fg) = w;
            }
#pragma unroll
            for (int itx = 0; itx < VIT; ++itx) {
                const int item = itx * NTHREADS + tid, t8 = item & 7, e = item >> 3;
                const u32x4 w = *(const LAS u32x4*)(Vt + e * PSTR + t8 * 8);
                { const int o = (((e >> 4) * 2 + (t8 >> 2)) * 512) + (((t8 & 3) * 16 + (e & 15)) * 8);
                  *(u32x4*)(V + (size_t)(token0 + o / DVC) * DVT + h * DV + e0 + (o % DVC)) = w; }
            }
            LDS_BAR();
        }
    }
}

#undef PREP_LOAD
template <int DK, int DV, int H, int NS, int UNR, int NE>
__device__ __forceinline__ void scan_phase(LAS unsigned char* L, int tid, const bf16_t* Qh, const bf16_t* Ktt, const bf16_t* Vtp, bf16_t* OI, const float* GA, float* SS, unsigned* dummy, unsigned* grp) {
    constexpr int DKT = DK * H, DVT = DV * H, NSL = DV / 16, NSLB = NSL / NE, TPW = DK / 128, NKS = DK / 32, SSTR = DK + 8, DVC = (DV > 256) ? 256 : DV, EPRC = DVC / 64, NBH = NBATCH * H;
    static_assert(UNR % NS == 0 && NSL % NE == 0, "scan geometry");
    LAS bf16_t* St = (LAS bf16_t*)L;
    const int lane = tid & 63, wid = __builtin_amdgcn_readfirstlane(tid >> 6), fr = lane & 15, fg = lane >> 4;
    for (int item = blockIdx.x; item < NBH * NSLB; item += gridDim.x) {
        const int xc = item & 7, jx = item >> 3, bh = xc + 8 * (jx / NSLB), slb = jx % NSLB;
        const int b = bh / H, h = bh % H, ecol0 = h * DV + slb * 16 * NE;
        f32x4 S[TPW][NE];
#pragma unroll
        for (int t = 0; t < TPW; ++t)
#pragma unroll
            for (int j = 0; j < NE; ++j) S[t][j] = (f32x4){0.f, 0.f, 0.f, 0.f};
        bf16x8 kf[NS][TPW][2], qf[NS][NKS], vf[NS][NE][2]; f32x4 ga[NS][TPW]; u32x2 oi[NS][NE];
        constexpr int LPB = 2 * DK / NSLB, TD = NS + 2;
        static_assert(LPB <= 64, "scan geometry");
        constexpr bool TOUCH = false;
        unsigned tch[3] = {0u, 0u, 0u}, tacc = 0u;
        const int tli = slb * LPB + lane;
#define SCAN_LOAD(c, s) do { const int cgi_ = b * CPB + (c); const int tk0_ = cgi_ * CHUNK; \
        _Pragma("unroll") for (int t = 0; t < TPW; ++t) { const size_t d_ = (size_t)cgi_ * DKT + h * DK + (wid * TPW + t) * 16; \
            { const bf16_t* kp_ = Ktt + (((size_t)cgi_ * (DKT / 16) + (h * DK) / 16 + wid * TPW + t) * 2) * 512 + lane * 8; kf[s][t][0] = *(const bf16x8*)kp_; kf[s][t][1] = *(const bf16x8*)(kp_ + 512); } \
            ga[s][t] = *(const f32x4*)(GA + d_ + 4 * fg); } \
        _Pragma("unroll") for (int j = 0; j < NE; ++j) { const int ev_ = (slb * NE + j) * 16; \
            const int o0_ = (((ev_ % DVC) >> 4) * 2) * 512 + lane * 8, o1_ = o0_ + 512; const bf16_t* vb_ = Vtp + (size_t)tk0_ * DVT + h * DV + (ev_ / DVC) * DVC; \
            vf[s][j][0] = *(const bf16x8*)(vb_ + (size_t)(o0_ / DVC) * DVT + (o0_ % DVC)); vf[s][j][1] = *(const bf16x8*)(vb_ + (size_t)(o1_ / DVC) * DVT + (o1_ % DVC)); } \
        if (wid < 4) { _Pragma("unroll") for (int ks = 0; ks < NKS; ++ks) { const int o_ = (wid * NKS + ks) * 512 + lane * 8; qf[s][ks] = *(const bf16x8*)(Qh + (size_t)(tk0_ + o_ / DK) * DKT + h * DK + (o_ % DK)); } \
            _Pragma("unroll") for (int j = 0; j < NE; ++j) oi[s][j] = *(const u32x2*)(OI + ((((size_t)cgi_ * H + h) * NSL + slb * NE + j) * 64 + wid * 16 + fr) * 16 + 4 * fg); } } while (0)
#pragma unroll
        for (int s = 0; s < NS - 1; ++s) SCAN_LOAD(s, s);
#ifdef EXP_NOLOAD
        SCAN_LOAD(0, NS - 1);
#endif
#pragma unroll 1
        for (int c0 = 0; c0 < CPB; c0 += UNR) {
#pragma unroll
            for (int u = 0; u < UNR; ++u) {
                const int s = u % NS;
                const int c = c0 + u;
                if (CPB % UNR == 0 || c < CPB) {
#ifndef EXP_NOLOAD
                    { const int cl = (c + NS - 1 < CPB) ? c + NS - 1 : CPB - 1; SCAN_LOAD(cl, (u + NS - 1) % NS); }
#endif
                    if (TOUCH && wid == 7) { tacc ^= tch[u % 3];
                        if (lane < LPB) { const int ct = (c + TD < CPB) ? c + TD : CPB - 1; const int cgt = b * CPB + ct;
                            const bf16_t* tp = (tli < DK) ? Ktt + ((size_t)cgt * DKT + h * DK + tli) * 64
                                                          : Qh + (size_t)(cgt * CHUNK + (tli - DK) / (DK / 64)) * DKT + h * DK + ((tli - DK) % (DK / 64)) * 64;
                            tch[u % 3] = *(const unsigned*)tp; } }
                    const int token0 = (b * CPB + c) * CHUNK;
                    LAS bf16_t* Sb = St + (c & 1) * (16 * NE) * SSTR;
                    f32x4 dS[TPW][NE];
#pragma unroll
                    for (int t = 0; t < TPW; ++t)
#pragma unroll
                        for (int j = 0; j < NE; ++j) { dS[t][j] = (f32x4){0.f, 0.f, 0.f, 0.f};
                            dS[t][j] = __builtin_amdgcn_mfma_f32_16x16x32_bf16(kf[s][t][0], vf[s][j][0], dS[t][j], 0, 0, 0); dS[t][j] = __builtin_amdgcn_mfma_f32_16x16x32_bf16(kf[s][t][1], vf[s][j][1], dS[t][j], 0, 0, 0); }
#pragma unroll
                    for (int t = 0; t < TPW; ++t)
#pragma unroll
                        for (int j = 0; j < NE; ++j) { u32x2 w; w.x = cvt_pk_bf16(S[t][j][0], S[t][j][1]); w.y = cvt_pk_bf16(S[t][j][2], S[t][j][3]);
                            *(LAS u32x2*)(Sb + (j * 16 + fr) * SSTR + (wid * TPW + t) * 16 + 4 * fg) = w; }
#pragma unroll
                    for (int t = 0; t < TPW; ++t)
#pragma unroll
                        for (int j = 0; j < NE; ++j) S[t][j] = ga[s][t] * S[t][j] + dS[t][j];
                    LDS_BAR();
                    if (wid < 4) {
                        const size_t tok = (size_t)(token0 + wid * 16 + fr);
#pragma unroll
                        for (int j = 0; j < NE; ++j) {
                            f32x4 acc = {0.f, 0.f, 0.f, 0.f}, acc2 = {0.f, 0.f, 0.f, 0.f};
#pragma unroll
                            for (int ks = 0; ks < NKS; ks += 2) { const bf16x8 a = *(const LAS bf16x8*)(Sb + (j * 16 + fr) * SSTR + ks * 32 + fg * 8), a2 = *(const LAS bf16x8*)(Sb + (j * 16 + fr) * SSTR + (ks + 1) * 32 + fg * 8);
                                acc = __builtin_amdgcn_mfma_f32_16x16x32_bf16(a, qf[s][ks], acc, 0, 0, 0); acc2 = __builtin_amdgcn_mfma_f32_16x16x32_bf16(a2, qf[s][ks + 1], acc2, 0, 0, 0); }
                            acc = acc + acc2;
                            acc[0] += bflo(oi[s][j].x); acc[1] += bfhi(oi[s][j].x); acc[2] += bflo(oi[s][j].y); acc[3] += bfhi(oi[s][j].y);
                            u32x2 w; w.x = cvt_pk_bf16(acc[0], acc[1]); w.y = cvt_pk_bf16(acc[2], acc[3]);
                            *(u32x2*)(OI + ((((size_t)(b * CPB + c) * H + h) * NSL + slb * NE + j) * 64 + wid * 16 + fr) * 16 + 4 * fg) = w;
                        }
                    }
                }
            }
        }
#undef SCAN_LOAD
        if (TOUCH && wid == 7) dummy[blockIdx.x * 64 + lane] = tacc ^ tch[0] ^ tch[1] ^ tch[2];
        LDS_BAR();
    }
}

__device__ __forceinline__ void r_load_w(LAS unsigned char* L, int tid, const float* w_in1) {
    LAS bf16_t* wT = (LAS bf16_t*)L;
#pragma unroll
    for (int it = 0; it < 4; ++it) { const int k = it * NTHREADS + tid; const float* p = w_in1 + (size_t)k * GLA_IN + 6144;
#pragma unroll
        for (int q4 = 0; q4 < 4; ++q4) { const f32x4 v = *(const f32x4*)(p + 4 * q4);
#pragma unroll
            for (int q = 0; q < 4; ++q) wT[(4 * q4 + q) * 2056 + k] = (unsigned short)(cvt_pk_bf16(v[q], v[q]) & 0xffffu); } }
}
__device__ __forceinline__ void r_block(LAS unsigned char* L, int tid, int rb, const bf16_t* hn, float* R16) {
    const LAS bf16_t* wT = (const LAS bf16_t*)L;
    const int lane = tid & 63, wid = __builtin_amdgcn_readfirstlane(tid >> 6), fr = lane & 15, fg = lane >> 4;
    if (wid < 4) {
        const bf16_t* ap = hn + (size_t)(rb * 64 + wid * 16 + fr) * DM + fg * 8;
        f32x4 acc = {0.f, 0.f, 0.f, 0.f}, acc2 = {0.f, 0.f, 0.f, 0.f};
#pragma unroll 4
        for (int ks = 0; ks < DM / 32; ks += 2) {
            const bf16x8 b0 = *(const bf16x8*)(ap + ks * 32), b1 = *(const bf16x8*)(ap + ks * 32 + 32);
            const bf16x8 a0 = *(const LAS bf16x8*)(wT + fr * 2056 + ks * 32 + fg * 8), a1 = *(const LAS bf16x8*)(wT + fr * 2056 + ks * 32 + 32 + fg * 8);
            acc = __builtin_amdgcn_mfma_f32_16x16x32_bf16(a0, b0, acc, 0, 0, 0); acc2 = __builtin_amdgcn_mfma_f32_16x16x32_bf16(a1, b1, acc2, 0, 0, 0);
        }
        acc = acc + acc2;
        *(f32x4*)(R16 + (size_t)(rb * 64 + wid * 16 + fr) * 16 + 4 * fg) = acc;
    }
}

template <int DV, int H>
__device__ __forceinline__ void hn_phase(int gtid, int ngt, const bf16_t* OI, const bf16_t* G, const float* gain, bf16_t* A) {
    for (int i = gtid; i < MTOK * (DM / 8); i += ngt) {
        const int token = i >> 8, col = (i & 255) * 8, head = col / DV;
        const int e_ = col % DV;
        const u32x4 ow = *(const u32x4*)(OI + ((((size_t)(token >> 6) * H + head) * (DV / 16) + (e_ >> 4)) * 64 + (token & 63)) * 16 + (e_ & 15)), gw = *(const u32x4*)(G + (size_t)token * DM + col);
        const f32x4 g0 = *(const f32x4*)(gain + (col % DV)), g1 = *(const f32x4*)(gain + (col % DV) + 4);
        float o[8] = {bflo(ow.x), bfhi(ow.x), bflo(ow.y), bfhi(ow.y), bflo(ow.z), bfhi(ow.z), bflo(ow.w), bfhi(ow.w)};
        float ss = 0.f;
#pragma unroll
        for (int q = 0; q < 8; ++q) ss += o[q] * o[q];
#pragma unroll
        for (int m = 1; m < DV / 8; m <<= 1) ss += __shfl_xor(ss, m);
        const float rstd = rsqrtf(ss * (1.f / DV) + NEPS);
        float gt[8] = {bflo(gw.x), bfhi(gw.x), bflo(gw.y), bfhi(gw.y), bflo(gw.z), bfhi(gw.z), bflo(gw.w), bfhi(gw.w)};
        float r[8];
#pragma unroll
        for (int q = 0; q < 8; ++q) { const float gn = (q < 4) ? g0[q & 3] : g1[q & 3]; r[q] = o[q] * rstd * gn * (gt[q] / (1.f + __expf(-gt[q]))); }
        u32x4 w; w.x = cvt_pk_bf16(r[0], r[1]); w.y = cvt_pk_bf16(r[2], r[3]); w.z = cvt_pk_bf16(r[4], r[5]); w.w = cvt_pk_bf16(r[6], r[7]);
        *(u32x4*)(A + (size_t)token * DM + col) = w;
    }
}

#define XB_TMO      128
#define XB_XCNT(j)  (256  + 64 * (j))
#define XB_XSUB(j)  (1280 + 64 * (j))
#define XB_XGEN(j)  (2304 + 64 * (j))
#define XB_TOP      3328
#define XB_TOPGEN   3392
#define XCD_BAR_WORDS 3456
#define XB_SPIN_CAP (1u << 18)

__device__ __forceinline__ unsigned xb_ld(unsigned* p)              { return __hip_atomic_load(p, __ATOMIC_RELAXED, __HIP_MEMORY_SCOPE_AGENT); }
__device__ __forceinline__ unsigned xb_add(unsigned* p, unsigned v) { return __hip_atomic_fetch_add(p, v, __ATOMIC_RELAXED, __HIP_MEMORY_SCOPE_AGENT); }
__device__ __forceinline__ unsigned xb_xcc_id() { return (unsigned)__builtin_amdgcn_s_getreg((3 << 11) | 20) & 0xFu; }
#define XB_SPIN(cond, bar) do { unsigned _sp = 0; while (cond) { __builtin_amdgcn_s_sleep(1); \
    if ((++_sp & 255u) == 0u) { if (xb_ld(&(bar)[XB_TMO])) break; if (_sp > XB_SPIN_CAP) { atomicAdd(&(bar)[XB_TMO], 1u); break; } } } } while (0)

struct XcdBarrier {
    unsigned* bar; unsigned x;
    volatile LAS unsigned* st;
};

__device__ __forceinline__ XcdBarrier xcd_barrier_post(unsigned* bar, volatile LAS unsigned* st) {
    XcdBarrier b; b.bar = bar; b.x = xb_xcc_id(); b.st = st;
    if (threadIdx.x == 0) (void)xb_add(&bar[XB_XCNT(b.x)], 1u);
    return b;
}
__device__ __forceinline__ void xcd_barrier_complete(unsigned* bar, unsigned x, unsigned& nloc, unsigned& nx) {
    const unsigned G = gridDim.x * gridDim.y * gridDim.z;
    unsigned sum, cnt, mine, sp = 0u;
    for (;;) {
        sum = 0u; cnt = 0u; mine = 0u;
#pragma unroll
        for (unsigned j = 0; j < 16; ++j) { const unsigned c = xb_ld(&bar[XB_XCNT(j)]); sum += c; cnt += (c > 0u) ? 1u : 0u; mine = (j == x) ? c : mine; }
        if (sum == G) break;
        __builtin_amdgcn_s_sleep(1);
        if ((++sp & 255u) == 0u) { if (xb_ld(&bar[XB_TMO])) break; if (sp > XB_SPIN_CAP) { atomicAdd(&bar[XB_TMO], 1u); break; } }
    }
    nloc = mine > 0u ? mine : 1u; nx = cnt > 0u ? cnt : 1u;
}

__device__ __forceinline__ void xcd_barrier(const XcdBarrier& b) {
    asm volatile("s_waitcnt vmcnt(0)" ::: "memory");
    __syncthreads();
    if (threadIdx.x == 0) {
        unsigned* bar = b.bar;
        __builtin_amdgcn_s_waitcnt(0);
        unsigned nloc = b.st[0], nx = b.st[1];
        if (nloc == 0u) { xcd_barrier_complete(bar, b.x, nloc, nx); b.st[0] = nloc; b.st[1] = nx; }
        const unsigned old = xb_add(&bar[XB_XSUB(b.x)], 1u);
        const unsigned gen = old / nloc;
        if (old + 1u == (gen + 1u) * nloc) {
            __builtin_amdgcn_fence(__ATOMIC_RELEASE, "agent");
            asm volatile("s_waitcnt vmcnt(0)" ::: "memory");
            const unsigned og = xb_add(&bar[XB_TOP], 1u);
            const unsigned tg = og / nx;
            if (og + 1u == (tg + 1u) * nx) xb_add(&bar[XB_TOPGEN], 1u);
            else XB_SPIN(xb_ld(&bar[XB_TOPGEN]) == tg, bar);
            __builtin_amdgcn_fence(__ATOMIC_ACQUIRE, "agent");
            xb_add(&bar[XB_XGEN(b.x)], 1u);
            asm volatile("s_waitcnt vmcnt(0)" ::: "memory");
        } else {
            XB_SPIN(xb_ld(&bar[XB_XGEN(b.x)]) == gen, bar);
            __builtin_amdgcn_fence(__ATOMIC_ACQUIRE, "agent");
            asm volatile("s_waitcnt vmcnt(0)" ::: "memory");
        }
    }
    __syncthreads();
}

struct Args { const float* in[16]; float* out; unsigned char* ws; int ph_lo, ph_hi; };
__global__ void __launch_bounds__(NTHREADS, 2) fwd_kernel(Args args) {
    __shared__ __attribute__((aligned(16))) unsigned char lds_raw[LDS_BYTES];
    LAS unsigned char* L = (LAS unsigned char*)lds_raw;
    const int tid = threadIdx.x, lane = tid & 63, wave = __builtin_amdgcn_readfirstlane(tid >> 6);
    const int G = gridDim.x, gw = blockIdx.x * 8 + wave, ngw = G * 8, gtid = blockIdx.x * NTHREADS + tid, ngt = G * NTHREADS;
    unsigned char* ws = args.ws; float* dout = args.out;
    const float* x = args.in[0]; const float* n_mix_pre = args.in[1]; const float* n_mix_post = args.in[2]; const float* n_mlp_pre = args.in[3]; const float* n_mlp_post = args.in[4];
    bf16_t* A = (bf16_t*)(ws + WS_A); bf16_t* Fb = (bf16_t*)(ws + WS_F);
    cg::grid_group grid = cg::this_grid();
    if (tid < 16) ((LAS unsigned*)(L + MISC_OFF))[tid] = 0u;
    __syncthreads();
    XcdBarrier xbar = xcd_barrier_post((unsigned*)(ws + WS_CTL), (volatile LAS unsigned*)(L + MISC_OFF));
#ifdef PROBE_XCC
    if (tid == 0) __hip_atomic_fetch_or((unsigned*)(ws + WS_CTL) + 12288 + (blockIdx.x & 7) * 64, 1u << xbar.x, __ATOMIC_RELAXED, __HIP_MEMORY_SCOPE_AGENT);
#endif
#ifdef PROBE_PH
    unsigned long long t_probe0 = 0, t_probe1 = 0;
#define PROBE_AT(k) do { if ((k) == PROBE_PH) t_probe0 = __builtin_amdgcn_s_memrealtime(); if ((k) == PROBE_PH + 1) t_probe1 = __builtin_amdgcn_s_memrealtime(); } while (0)
#else
#define PROBE_AT(k) do {} while (0)
#endif
    const int lo = args.ph_lo, hi = args.ph_hi;
#define IN(k) (lo <= (k) && (k) < hi)
#define SEAM(k) do { if (IN(k) && IN((k) + 1)) { if (args.ph_hi > NPH) grid.sync(); else xcd_barrier(xbar); } PROBE_AT((k) + 1); } while (0)
#define GEMM_PHASE(CFG, Aptr, Bptr, N_, K_) do { pg8::Gemm g{(const bf16_t*)(Aptr), (const bf16_t*)(Bptr), MTOK, (N_), (K_)}; pg8::StaticOrder S; S.init(MTOK, (N_), G, (int)blockIdx.x); \
        Epi<CFG> E{ws, dout}; pg8::gemm_phase<Epi<CFG>, pg8::StaticOrder, false, true>(L, g, S, E); } while (0)
    float* GA = (float*)(ws + WS_GA); float* SSp = (float*)(ws + WS_SS);
    PROBE_AT(0);
    if (IN(PH_PRO)) {
        convert_layer(L, gw, ngw, wave, lane, 1, args.in[5], DFF, DFF, DFF, args.in[8], args.in[14], args.in[15],
                      (bf16_t*)(ws + W0IN), (bf16_t*)(ws + W0OUT), (bf16_t*)(ws + W0UP), (bf16_t*)(ws + W0DN));
        { const float* lg = args.in[6]; float* lb = (float*)(ws + WS_LB);
          for (int i = gtid; i < DM; i += ngt) { const float a = lg[i], b = lg[DM + i], c = lg[2 * DM + i]; const float mx = fmaxf(a, fmaxf(b, c));
              const float ea = expf(a - mx), eb = expf(b - mx), ec = expf(c - mx); lb[i] = ea / (ea + eb + ec); } }
        row_pass(gw, ngw, lane, nullptr, x, nullptr, nullptr, n_mix_pre, A);
    }
    SEAM(PH_PRO);
    if (IN(PH_G1)) GEMM_PHASE(E_HGRN_IN, A, ws + W0IN, DFF, DM);
    SEAM(PH_G1);
    if (IN(PH_PREP0)) prep_phase<128, 128, 16, false>(L, tid, (bf16_t*)(ws + WS_Q), (const bf16_t*)(ws + WS_K0), dout, nullptr, nullptr, nullptr, (bf16_t*)(ws + WS_V), A, GA, Fb);
    SEAM(PH_PREP0);
    if (IN(PH_SCAN0)) {
        constexpr int SCAN0_ITEMS = NBATCH * 16 * (128 / 32);
        if ((int)blockIdx.x < SCAN0_ITEMS || G <= SCAN0_ITEMS) scan_phase<128, 128, 16, 3, 12, 2>(L, tid, (const bf16_t*)(ws + WS_Q), A, (const bf16_t*)(ws + WS_V), Fb, GA, SSp, (unsigned*)(ws + WS_CTL + 65536), (unsigned*)(ws + WS_CTL) + 4096 + 0 * 2048);
        if (G <= SCAN0_ITEMS) { __syncthreads(); convert_layer(L, gw, ngw, wave, lane, 14, args.in[5], DFF, DFF, DFF, args.in[8], args.in[14], args.in[15], (bf16_t*)(ws + W0IN), (bf16_t*)(ws + W0OUT), (bf16_t*)(ws + W0UP), (bf16_t*)(ws + W0DN));
            convert_layer(L, gw, ngw, wave, lane, 3, args.in[9], GLA_IN, GLA_IN, GLA_NPAD, args.in[13], nullptr, nullptr, (bf16_t*)(ws + W1IN), (bf16_t*)(ws + W1OUT), nullptr, nullptr); }
        else if ((int)blockIdx.x >= SCAN0_ITEMS) {
            convert_layer(L, ((int)blockIdx.x - SCAN0_ITEMS) * 8 + wave, (G - SCAN0_ITEMS) * 8, wave, lane, 14, args.in[5], DFF, DFF, DFF, args.in[8], args.in[14], args.in[15],
                          (bf16_t*)(ws + W0IN), (bf16_t*)(ws + W0OUT), (bf16_t*)(ws + W0UP), (bf16_t*)(ws + W0DN));
            convert_layer(L, ((int)blockIdx.x - SCAN0_ITEMS) * 8 + wave, (G - SCAN0_ITEMS) * 8, wave, lane, 3, args.in[9], GLA_IN, GLA_IN, GLA_NPAD, args.in[13], nullptr, nullptr,
                          (bf16_t*)(ws + W1IN), (bf16_t*)(ws + W1OUT), nullptr, nullptr);
        }
    }
    SEAM(PH_SCAN0);
    if (IN(PH_HN0)) hn_phase<128, 16>(gtid, ngt, Fb, (const bf16_t*)(ws + WS_G), args.in[7], A);
    SEAM(PH_HN0);
    if (IN(PH_G2)) GEMM_PHASE(E_PLAIN, A, ws + W0OUT, DM, DM);
    SEAM(PH_G2);
    if (IN(PH_ROW0A)) row_pass(gw, ngw, lane, Fb, x, n_mix_post, dout, n_mlp_pre, A);
    SEAM(PH_ROW0A);
    if (IN(PH_G3)) GEMM_PHASE(E_RELU2, A, ws + W0UP, DFF, DM);
    SEAM(PH_G3);
    if (IN(PH_G4)) GEMM_PHASE(E_PLAIN, ws + WS_U, ws + W0DN, DM, DFF);
    SEAM(PH_G4);
    if (IN(PH_ROW0B)) {
        r_load_w(L, tid, args.in[9]);
        for (int rb = blockIdx.x; rb < MTOK / 64; rb += G) {
            row_pass(rb * 64 + wave * 8, 1, lane, Fb, dout, n_mlp_post, dout, n_mix_pre + DM, A, rb * 64 + wave * 8 + 8);
            asm volatile("s_waitcnt vmcnt(0)" ::: "memory"); __syncthreads();
            r_block(L, tid, rb, A, (float*)(ws + WS_R16));
        }
        __syncthreads();
        convert_layer(L, gw, ngw, wave, lane, 12, args.in[9], GLA_IN, GLA_IN, GLA_NPAD, args.in[13], args.in[14] + (size_t)DM * DFF, args.in[15] + (size_t)DM * DFF,
                      (bf16_t*)(ws + W1IN), (bf16_t*)(ws + W1OUT), (bf16_t*)(ws + W1UP), (bf16_t*)(ws + W1DN));
    }
    SEAM(PH_ROW0B);
    if (IN(PH_G5)) GEMM_PHASE(E_GLA_IN, A, ws + W1IN, GLA_NPAD, DM);
    SEAM(PH_G5);
    if (IN(PH_PREP1)) prep_phase<256, 512, 4, true>(L, tid, (bf16_t*)(ws + WS_Q), (const bf16_t*)(ws + WS_K1), nullptr, (const float*)(ws + WS_R16), args.in[10], args.in[11], (bf16_t*)(ws + WS_V), A, GA, Fb);
    SEAM(PH_PREP1);
    if (IN(PH_SCAN1)) scan_phase<256, 512, 4, 2, 8, 1>(L, tid, (const bf16_t*)(ws + WS_Q), A, (const bf16_t*)(ws + WS_V), Fb, GA, SSp, (unsigned*)(ws + WS_CTL + 65536), (unsigned*)(ws + WS_CTL) + 4096 + 1 * 2048);
    SEAM(PH_SCAN1);
    if (IN(PH_HN1)) hn_phase<512, 4>(gtid, ngt, Fb, (const bf16_t*)(ws + WS_G), args.in[12], A);
    SEAM(PH_HN1);
    if (IN(PH_G6)) GEMM_PHASE(E_PLAIN, A, ws + W1OUT, DM, DM);
    SEAM(PH_G6);
    if (IN(PH_ROW1A)) row_pass(gw, ngw, lane, Fb, dout, n_mix_post + DM, dout, n_mlp_pre + DM, A);
    SEAM(PH_ROW1A);
    if (IN(PH_G7)) GEMM_PHASE(E_RELU2, A, ws + W1UP, DFF, DM);
    SEAM(PH_G7);
    if (IN(PH_G8)) GEMM_PHASE(E_PLAIN, ws + WS_U, ws + W1DN, DM, DFF);
    SEAM(PH_G8);
    if (IN(PH_ROW1B)) row_pass(gw, ngw, lane, Fb, dout, n_mlp_post + DM, dout, nullptr, nullptr);
#undef IN
#undef SEAM
#undef GEMM_PHASE
#ifdef PROBE_XCC
    if (blockIdx.x == 0 && tid == 0) { int bad = 0; unsigned all = 0; for (int i = 0; i < 8; ++i) { const unsigned m = __hip_atomic_load((unsigned*)(ws + WS_CTL) + 12288 + i * 64, __ATOMIC_RELAXED, __HIP_MEMORY_SCOPE_AGENT); bad += (__builtin_popcount(m) != 1); all |= m; }
        dout[0] += 100.f * (float)bad + (float)__builtin_popcount(all); }
#endif
#ifdef PROBE_PH
    PROBE_AT(NPH);
    if (blockIdx.x == 0 && tid == 0) dout[0] += (float)(t_probe1 - t_probe0) * 0.001f;
#endif
#ifdef DIAG_PREFIX
    grid.sync();
    for (int i = gtid; i < MTOK * DM; i += ngt) {
        unsigned hsh = __float_as_uint(dout[i]); hsh = (hsh >> 16) ^ (hsh & 0xffffu);
        for (int k = 0; k < 8; ++k) { const size_t widx = (size_t)i + (size_t)k * 33554432u; if (widx * 2 < WS_END) hsh = hsh * 31u + ((const unsigned short*)ws)[widx]; }
        dout[i] = (float)(hsh & 0xffffu);
    }
#endif
}

extern "C" void kernel_launch(void* const* d_in, const int* in_sizes, int n_in, void* d_out, int out_size, void* d_ws, size_t ws_size, hipStream_t stream) {
    static int grid = 0;
    if (grid == 0) {
        if (n_in != 16 || out_size != MTOK * DM || ws_size < WS_END) { fprintf(stderr, "kernel_launch: unexpected shapes (n_in %d, out %d, ws %zu)\n", n_in, out_size, ws_size); grid = -1; return; }
        int dev = 0, cus = 0, per_cu = 0;
        (void)hipGetDevice(&dev); (void)hipDeviceGetAttribute(&cus, hipDeviceAttributeMultiprocessorCount, dev);
        if (hipOccupancyMaxActiveBlocksPerMultiprocessor(&per_cu, (const void*)fwd_kernel, NTHREADS, 0) != hipSuccess || per_cu < 1) { fprintf(stderr, "kernel_launch: occupancy query gave %d\n", per_cu); per_cu = 1; }
        (void)hipGetLastError();
        grid = cus;
    }
    if (grid < 0) return;
    Args a{};
    for (int i = 0; i < 16; ++i) a.in[i] = (const float*)d_in[i];
    a.out = (float*)d_out; a.ws = (unsigned char*)d_ws;
    void* kargs[] = {&a};
    if (hipMemsetAsync((char*)d_ws + WS_CTL, 0, CTL_BYTES, stream) != hipSuccess) { fprintf(stderr, "kernel_launch: hipMemsetAsync failed\n"); return; }
#if MK_N_LAUNCHES == 1
#ifdef DIAG_PREFIX
    a.ph_lo = 0; a.ph_hi = DIAG_PREFIX + 1;
#else
    a.ph_lo = 0; a.ph_hi = NPH;
#endif
    hipError_t e = hipLaunchCooperativeKernel((const void*)fwd_kernel, dim3(grid), dim3(NTHREADS), kargs, 0, stream);
    if (e != hipSuccess) fprintf(stderr, "kernel_launch: cooperative launch failed: %s (grid %d)\n", hipGetErrorString(e), grid);
#else
    for (int ph = 0; ph < NPH; ++ph) {
        a.ph_lo = ph; a.ph_hi = ph + 1;
        hipError_t e = hipLaunchCooperativeKernel((const void*)fwd_kernel, dim3(grid), dim3(NTHREADS), kargs, 0, stream);
        if (e != hipSuccess) { fprintf(stderr, "kernel_launch: launch of phase %d failed: %s (grid %d)\n", ph, hipGetErrorString(e), grid); break; }
    }
#endif
}
```
